# Optimizing an MI355X kernel written in HIP

```python
import jax, jax.numpy as jnp
from jax import lax
import numpy as np

D_MODEL = 1024
BATCH = 8
SEQ = 4096
DEPTH = 1

CHUNK = 64
D_RNN = 1024
RNN_BLOCKS = 16
RNN_BLOCK_DIM = D_RNN // RNN_BLOCKS
CONV_WIDTH = 4
LRU_C = 8.0
N_HEADS = 16
N_KV_HEADS = 4
HEAD_DIM = 64
D_ATTN = N_HEADS * HEAD_DIM
D_KV = N_KV_HEADS * HEAD_DIM
IDX_HEADS = 8
IDX_DIM = 64
TOPK_MAX = 256
D_FF = 4 * D_MODEL
N_BRANCHES = 2
EPS = 1e-6
SPLITS = (D_RNN, D_RNN, D_ATTN, D_KV, D_KV, IDX_HEADS * IDX_DIM, IDX_DIM, IDX_HEADS, N_BRANCHES * D_MODEL)
D_IN = D_RNN + D_RNN + D_ATTN + D_KV + D_KV + IDX_HEADS * IDX_DIM + IDX_DIM + IDX_HEADS + N_BRANCHES * D_MODEL

kernel_name = "hybrid_rglru_dsa_block"


def rms_norm(x, w):
    xf = x.astype(jnp.float32)
    y = xf * lax.rsqrt(jnp.mean(xf * xf, axis=-1, keepdims=True) + EPS)
    return (y * w.astype(jnp.float32)).astype(x.dtype)


def causal_depthwise_conv(x, w, b):
    T = x.shape[1]
    xp = jnp.pad(x, ((0, 0), (CONV_WIDTH - 1, 0), (0, 0)))
    out = b
    for j in range(CONV_WIDTH):
        out = out + xp[:, j:j + T] * w[j]
    return out


def block_diag_linear(x, w, b):
    xb = x.reshape(x.shape[:-1] + (RNN_BLOCKS, RNN_BLOCK_DIM))
    y = jnp.einsum('btnd,nde->btne', xb, w)
    return y.reshape(x.shape) + b


def rg_lru(x, wa, ba, wx, bx, lam):
    r = jax.nn.sigmoid(block_diag_linear(x, wa, ba).astype(jnp.float32))
    i = jax.nn.sigmoid(block_diag_linear(x, wx, bx).astype(jnp.float32))
    log_a = -LRU_C * r * jax.nn.softplus(-lam.astype(jnp.float32))
    a = jnp.exp(log_a)
    mult = jnp.sqrt(-jnp.expm1(2.0 * log_a))
    u = mult * (i * x.astype(jnp.float32))

    def combine(c1, c2):
        a1, b1 = c1
        a2, b2 = c2
        return a1 * a2, a2 * b1 + b2

    _, h = lax.associative_scan(combine, (a, u), axis=1)
    return h.astype(x.dtype)


def dsa_attention(q, k, v, iq, ik, iw):
    B, T = q.shape[0], q.shape[1]
    n_chunks = T // CHUNK
    top_k = min(TOPK_MAX, T // 4)
    group = N_HEADS // N_KV_HEADS
    scale = HEAD_DIM ** -0.5
    idx_scale = (IDX_DIM ** -0.5) * (IDX_HEADS ** -0.5)
    key_pos = jnp.arange(T)

    def one_chunk(c):
        start = c * CHUNK
        qc = lax.dynamic_slice_in_dim(q, start, CHUNK, axis=1)
        iqc = lax.dynamic_slice_in_dim(iq, start, CHUNK, axis=1)
        iwc = lax.dynamic_slice_in_dim(iw, start, CHUNK, axis=1)
        limit = start + CHUNK
        visible = key_pos < limit
        rel = jax.nn.relu(jnp.einsum('bqhd,bsd->bqhs', iqc, ik).astype(jnp.float32))
        score = jnp.einsum('bqhs,bqh->bqs', rel, iwc.astype(jnp.float32)) * idx_scale
        score = jnp.where(visible, score, -jnp.inf)
        _, idx = lax.top_k(score, top_k)
        valid = idx < limit
        k_sel = jax.vmap(lambda kb, ib: kb[ib])(k, idx)
        v_sel = jax.vmap(lambda vb, ib: vb[ib])(v, idx)
        qg = qc.reshape(B, CHUNK, N_KV_HEADS, group, HEAD_DIM)
        s = jnp.einsum('bqgrd,bqkgd->bqgrk', qg, k_sel).astype(jnp.float32) * scale
        s = jnp.where(valid[:, :, None, None, :], s, -jnp.inf)
        p = jax.nn.softmax(s, axis=-1).astype(v.dtype)
        o = jnp.einsum('bqgrk,bqkgd->bqgrd', p, v_sel)
        return o.reshape(B, CHUNK, D_ATTN)

    out = lax.map(one_chunk, jnp.arange(n_chunks))
    return out.transpose(1, 0, 2, 3).reshape(B, T, D_ATTN)


def hybrid_layer(x, norm1_w, w_in, conv_w, conv_b, rg_wa, rg_ba, rg_wx, rg_bx, rg_lambda,
                 q_norm_w, k_norm_w, idx_k_norm_w, w_o_rnn, w_o_attn, gate_b, w_out,
                 norm2_w, w_ff_in, w_ff_out):
    B, T, _ = x.shape
    h = rms_norm(x, norm1_w)
    u = h @ w_in
    offsets = np.cumsum(SPLITS)[:-1].tolist()
    rnn_x, rnn_gate, q, k, v, iq, ik, iw, g = jnp.split(u, offsets, axis=-1)

    xc = causal_depthwise_conv(rnn_x, conv_w, conv_b)
    y_rnn = rg_lru(xc, rg_wa, rg_ba, rg_wx, rg_bx, rg_lambda) * jax.nn.gelu(rnn_gate)

    q = rms_norm(q.reshape(B, T, N_HEADS, HEAD_DIM), q_norm_w)
    k = rms_norm(k.reshape(B, T, N_KV_HEADS, HEAD_DIM), k_norm_w)
    v = v.reshape(B, T, N_KV_HEADS, HEAD_DIM)
    iq = iq.reshape(B, T, IDX_HEADS, IDX_DIM)
    ik = rms_norm(ik, idx_k_norm_w)
    y_attn = dsa_attention(q, k, v, iq, ik, iw)

    gates = jax.nn.sigmoid((g + gate_b.reshape(-1)).astype(jnp.float32)).astype(x.dtype)
    gates = gates.reshape(B, T, N_BRANCHES, D_MODEL)
    merged = gates[:, :, 0] * (y_rnn @ w_o_rnn) + gates[:, :, 1] * (y_attn @ w_o_attn)
    x = x + merged @ w_out

    h2 = rms_norm(x, norm2_w)
    x = x + jnp.square(jax.nn.relu(h2 @ w_ff_in)) @ w_ff_out
    return x


def setup_inputs(seed: int = 0) -> dict:
    key = jax.random.key(seed)
    ks = jax.random.split(key, 24)
    f32 = jnp.float32

    def nrm(k, shape, scale):
        return jax.random.normal(k, shape, f32) * scale

    a0 = jax.random.uniform(ks[9], (DEPTH, D_RNN), f32, 0.9, 0.999) ** (1.0 / LRU_C)
    rg_lambda = jnp.log(a0) - jnp.log1p(-a0)
    return {
        "x": nrm(ks[0], (BATCH, SEQ, D_MODEL), 1.0),
        "norm1_w": 1.0 + nrm(ks[1], (DEPTH, D_MODEL), 0.02),
        "w_in": nrm(ks[2], (DEPTH, D_MODEL, D_IN), D_MODEL ** -0.5),
        "conv_w": nrm(ks[3], (DEPTH, CONV_WIDTH, D_RNN), CONV_WIDTH ** -0.5),
        "conv_b": nrm(ks[4], (DEPTH, D_RNN), 0.02),
        "rg_wa": nrm(ks[5], (DEPTH, RNN_BLOCKS, RNN_BLOCK_DIM, RNN_BLOCK_DIM), RNN_BLOCK_DIM ** -0.5),
        "rg_ba": nrm(ks[6], (DEPTH, D_RNN), 0.02),
        "rg_wx": nrm(ks[7], (DEPTH, RNN_BLOCKS, RNN_BLOCK_DIM, RNN_BLOCK_DIM), RNN_BLOCK_DIM ** -0.5),
        "rg_bx": nrm(ks[8], (DEPTH, D_RNN), 0.02),
        "rg_lambda": rg_lambda,
        "q_norm_w": 1.0 + nrm(ks[10], (DEPTH, HEAD_DIM), 0.02),
        "k_norm_w": 1.0 + nrm(ks[11], (DEPTH, HEAD_DIM), 0.02),
        "idx_k_norm_w": 1.0 + nrm(ks[12], (DEPTH, IDX_DIM), 0.02),
        "w_o_rnn": nrm(ks[13], (DEPTH, D_RNN, D_MODEL), D_RNN ** -0.5),
        "w_o_attn": nrm(ks[14], (DEPTH, D_ATTN, D_MODEL), D_ATTN ** -0.5),
        "gate_b": nrm(ks[15], (DEPTH, N_BRANCHES, D_MODEL), 0.02),
        "w_out": nrm(ks[16], (DEPTH, D_MODEL, D_MODEL), D_MODEL ** -0.5),
        "norm2_w": 1.0 + nrm(ks[17], (DEPTH, D_MODEL), 0.02),
        "w_ff_in": nrm(ks[18], (DEPTH, D_MODEL, D_FF), D_MODEL ** -0.5),
        "w_ff_out": nrm(ks[19], (DEPTH, D_FF, D_MODEL), D_FF ** -0.5),
    }


def reference(x, norm1_w, w_in, conv_w, conv_b, rg_wa, rg_ba, rg_wx, rg_bx, rg_lambda,
              q_norm_w, k_norm_w, idx_k_norm_w, w_o_rnn, w_o_attn, gate_b, w_out,
              norm2_w, w_ff_in, w_ff_out):
    for l in range(DEPTH):
        x = hybrid_layer(x, norm1_w[l], w_in[l], conv_w[l], conv_b[l], rg_wa[l], rg_ba[l],
                         rg_wx[l], rg_bx[l], rg_lambda[l], q_norm_w[l], k_norm_w[l],
                         idx_k_norm_w[l], w_o_rnn[l], w_o_attn[l], gate_b[l], w_out[l],
                         norm2_w[l], w_ff_in[l], w_ff_out[l])
    return x
```

```cpp
#include <hip/hip_runtime.h>
#include <hip/hip_cooperative_groups.h>
#include <cstdio>
namespace pg8 {
#define PG8_LAS __attribute__((address_space(3)))
typedef unsigned short bf16_t;
typedef short bf16x8 __attribute__((ext_vector_type(8)));
typedef float f32x4 __attribute__((ext_vector_type(4)));
typedef unsigned u32x4 __attribute__((ext_vector_type(4)));
constexpr int BM = 256, BK = 64, HALF = 128, HTB = HALF * BK * 2  , STAGE_BYTES = 8 * HTB, NXCD = 8, WGM = 8;

__host__ __device__ __forceinline__ int lds_byte(int r, int c) { const int st = (r >> 4) * 2 + (c >> 5), rr = r & 15, cc = c & 31, ob = rr * 64 + cc * 2; return st * 1024 + (ob ^ (((ob >> 9) & 1) << 5)); }
__host__ __device__ __forceinline__ void stage_rc(int b, int& R, int& C) { const int st = b / 1024, sb = b % 1024, swz = sb ^ (((sb >> 9) & 1) << 5); R = (st >> 1) * 16 + swz / 64; C = (st & 1) * 32 + (swz % 64) / 2; }
__host__ __device__ __forceinline__ int perm32(int rho) { const int n = rho >> 4, i = rho & 15; return 8 * (i >> 2) + 4 * n + (i & 3); }

struct Unit { int pm, pn; };
struct Gemm { const bf16_t* A; const bf16_t* Bt; int M, N, K; };

struct StaticOrder {
    int nM, nN, nwg, G, c;
    __host__ __device__ void init(int M, int N, int G_, int c_) { nM = M / BM; nN = N / BM; nwg = nM * nN; G = G_; c = c_; }
    __host__ __device__ bool next(int i, Unit& u) const {
        const long L = (long)i * G + c; if (L >= nwg) return false;
        int wgid = (int)L; { const int q = nwg / NXCD, r = nwg % NXCD, xcd = wgid % NXCD, off = wgid / NXCD; wgid = (xcd < r ? xcd * (q + 1) : r * (q + 1) + (xcd - r) * q) + off; }
        const int nig = WGM * nN, gid = wgid / nig, fm = gid * WGM, gsz = (nM - fm) < WGM ? (nM - fm) : WGM;
        u.pm = fm + ((wgid % nig) % gsz); u.pn = (wgid % nig) / gsz; return true;
    }
    __device__ __forceinline__ void a_ready(const Unit&) const {}
    __device__ __forceinline__ void done(const Unit&) const {}
};
__device__ __forceinline__ unsigned cvt_pk_bf16(float lo, float hi) { unsigned r; asm volatile("v_cvt_pk_bf16_f32 %0, %1, %2" : "=v"(r) : "v"(lo), "v"(hi)); return r; }
typedef float f32x2 __attribute__((ext_vector_type(2)));

template <class Epi, class Sched, bool STAMP = false>
__device__ __forceinline__ void gemm_phase(PG8_LAS unsigned char* lds, const Gemm g, const Sched& S, const Epi& E, unsigned long long* stamps) {
    const int tid = threadIdx.x, wid = __builtin_amdgcn_readfirstlane(tid >> 6), lane = tid & 63, wr = wid >> 2, wc = wid & 3, fr = lane & 15, fq = lane >> 4;
    const int K = g.K, nt = K / BK;
    int ts_lo = 0, ts_hi = 0, nts = 0; const unsigned long long rt_entry = STAMP ? (unsigned long long)wall_clock64() : 0ull;
#define PG8_STAMP() do { if (STAMP && wid == 0 && nts < 64) { const unsigned long long _c = (unsigned long long)clock64(); \
        ts_lo = (lane == nts) ? (int)(unsigned)_c : ts_lo; ts_hi = (lane == nts) ? (int)(unsigned)(_c >> 32) : ts_hi; ++nts; } } while (0)
    PG8_STAMP();
    unsigned voffA[2], voffB[2];
#pragma unroll
    for (int i = 0; i < 2; ++i) { int R, C; stage_rc(tid * 16 + i * 8192, R, C); const int Rb = Epi::PERM ? ((R & ~31) + perm32(R & 31)) : R;
        voffA[i] = (unsigned)(R * K + C) * 2u; voffB[i] = (unsigned)(Rb * K + C) * 2u; }
    const size_t kstep = (size_t)(BK * 2);
    const size_t hstep = (size_t)HALF * K * 2;
    const size_t tstep = 2 * hstep;
    const unsigned ldsw = (unsigned)wid * 1024u;
    const int aoff = lds_byte(wr * 64 + fr, fq * 8), boff = lds_byte(wc * 32 + fr, fq * 8);
#define PG8_SA(b, h) (((b) * 2 + (h)) * HTB)
#define PG8_SB(b, h) ((4 + (b) * 2 + (h)) * HTB)
#define PG8_STAGE(bufoff, gbase, voff) do { _Pragma("unroll") for (int _i = 0; _i < 2; ++_i) \
        __builtin_amdgcn_global_load_lds((const unsigned*)((const char*)(gbase) + (voff)[_i]), (PG8_LAS unsigned*)(lds + (bufoff) + ldsw + _i * 8192), 16, 0, 0); } while (0)
#define PG8_LDA(dst, b, h) do { _Pragma("unroll") for (int m = 0; m < 4; ++m) _Pragma("unroll") for (int k = 0; k < 2; ++k) dst[m][k] = *(const PG8_LAS bf16x8*)(lds + PG8_SA(b, h) + aoff + m * 2048 + k * 1024); } while (0)
#define PG8_LDB(dst, b, h) do { _Pragma("unroll") for (int n = 0; n < 2; ++n) _Pragma("unroll") for (int k = 0; k < 2; ++k) dst[n][k] = *(const PG8_LAS bf16x8*)(lds + PG8_SB(b, h) + boff + n * 2048 + k * 1024); } while (0)
#define PG8_MMA(ai, bj, At, Bt) do { __builtin_amdgcn_s_setprio(1); _Pragma("unroll") for (int m = 0; m < 4; ++m) _Pragma("unroll") for (int n = 0; n < 2; ++n) _Pragma("unroll") for (int k = 0; k < 2; ++k) \
        acc[ai][bj][m][n] = __builtin_amdgcn_mfma_f32_16x16x32_bf16(Bt[n][k], At[m][k], acc[ai][bj][m][n], 0, 0, 0); __builtin_amdgcn_s_setprio(0); } while (0)
#define PG8_WAIT_V(n) asm volatile("s_waitcnt vmcnt(" #n ")" ::: "memory")
#define PG8_WAIT_L(n) asm volatile("s_waitcnt lgkmcnt(" #n ")" ::: "memory")
#define PG8_BAR __builtin_amdgcn_s_barrier()
#define PG8_SCHED __builtin_amdgcn_sched_barrier(0)
    Unit cur, nxt; int ui = 0;
    if (!S.next(0, cur)) return;
    f32x4 acc[2][2][4][2];
#pragma unroll
    for (int a = 0; a < 2; ++a)
#pragma unroll
        for (int b = 0; b < 2; ++b)
#pragma unroll
            for (int m = 0; m < 4; ++m)
#pragma unroll
                for (int n = 0; n < 2; ++n) acc[a][b][m][n] = (f32x4){0.f, 0.f, 0.f, 0.f};
    bf16x8 At[4][2], B0[2][2], B1[2][2];
    const char* cA = (const char*)g.A + (size_t)cur.pm * tstep; const char* cB = (const char*)g.Bt + (size_t)cur.pn * tstep;
    S.a_ready(cur);
    PG8_STAGE(PG8_SB(0, 0), cB, voffB); PG8_STAGE(PG8_SA(0, 0), cA, voffA); PG8_STAGE(PG8_SB(0, 1), cB + hstep, voffB); PG8_STAGE(PG8_SA(0, 1), cA + hstep, voffA);
    if (wr == 1) PG8_BAR;
    PG8_WAIT_V(4); PG8_BAR;
    PG8_STAGE(PG8_SB(1, 0), cB + kstep, voffB); PG8_STAGE(PG8_SA(1, 0), cA + kstep, voffA); PG8_STAGE(PG8_SB(1, 1), cB + hstep + kstep, voffB);
    PG8_WAIT_V(6); PG8_BAR;
    PG8_STAMP();
    for (;;) {
        const bool has_next = S.next(ui + 1, nxt);
        const char* nA = has_next ? (const char*)g.A + (size_t)nxt.pm * tstep : cA; const char* nB = has_next ? (const char*)g.Bt + (size_t)nxt.pn * tstep : cB;
        for (int t = 0; t < nt; t += 2) {
            const bool last = (t == nt - 2);
            const char* a1 = cA + (size_t)(t + 1) * kstep;
            const char* a2 = last ? nA : cA + (size_t)(t + 2) * kstep; const char* b2 = last ? nB : cB + (size_t)(t + 2) * kstep;
            const char* a3 = a2 + kstep; const char* b3 = b2 + kstep;
            if (last && has_next) S.a_ready(nxt);
            PG8_LDB(B0, 0, 0); PG8_SCHED; PG8_LDA(At, 0, 0); PG8_STAGE(PG8_SA(1, 1), a1 + hstep, voffA);
            PG8_WAIT_L(8); PG8_BAR; PG8_WAIT_L(0); PG8_MMA(0, 0, At, B0); PG8_BAR; PG8_SCHED;
            PG8_LDB(B1, 0, 1); PG8_STAGE(PG8_SB(0, 0), b2, voffB);
            PG8_BAR; PG8_WAIT_L(0); PG8_MMA(0, 1, At, B1); PG8_BAR;
            PG8_LDA(At, 0, 1); PG8_STAGE(PG8_SA(0, 0), a2, voffA);
            PG8_BAR; PG8_WAIT_L(0); PG8_MMA(1, 0, At, B0); PG8_BAR; PG8_SCHED;
            PG8_STAGE(PG8_SB(0, 1), b2 + hstep, voffB);
            PG8_WAIT_V(6); PG8_BAR; PG8_MMA(1, 1, At, B1); PG8_BAR;
            PG8_LDB(B0, 1, 0); PG8_SCHED; PG8_LDA(At, 1, 0); PG8_STAGE(PG8_SA(0, 1), a2 + hstep, voffA);
            PG8_WAIT_L(8); PG8_BAR; PG8_WAIT_L(0); PG8_MMA(0, 0, At, B0); PG8_BAR; PG8_SCHED;
            PG8_LDB(B1, 1, 1); PG8_STAGE(PG8_SB(1, 0), b3, voffB);
            PG8_BAR; PG8_WAIT_L(0); PG8_MMA(0, 1, At, B1); PG8_BAR;
            PG8_LDA(At, 1, 1); PG8_STAGE(PG8_SA(1, 0), a3, voffA);
            PG8_BAR; PG8_WAIT_L(0); PG8_MMA(1, 0, At, B0); PG8_BAR; PG8_SCHED;
            PG8_STAGE(PG8_SB(1, 1), b3 + hstep, voffB);
            PG8_WAIT_V(6); PG8_BAR; PG8_MMA(1, 1, At, B1); PG8_BAR;
        }
        PG8_STAMP();
        if constexpr (!Epi::AFTER_DRAIN) { E(acc, cur, wr, wc, fr, fq); S.done(cur); }
        PG8_STAMP();
        if (!has_next) break;
#pragma unroll
        for (int a = 0; a < 2; ++a)
#pragma unroll
            for (int b = 0; b < 2; ++b)
#pragma unroll
                for (int m = 0; m < 4; ++m)
#pragma unroll
                    for (int n = 0; n < 2; ++n) acc[a][b][m][n] = (f32x4){0.f, 0.f, 0.f, 0.f};
        cur = nxt; cA = nA; cB = nB; ++ui;
    }
    PG8_WAIT_V(0);
    if (wr == 0) PG8_BAR;
    PG8_BAR;
    if constexpr (Epi::AFTER_DRAIN) { E.fused(acc, cur, wr, wc, fr, fq, lds, wid, lane); S.done(cur); }
    PG8_STAMP();
    if (STAMP && wid == 0) { stamps[lane] = lane < nts ? (((unsigned long long)(unsigned)ts_hi << 32) | (unsigned)ts_lo) : 0ull;
        if (lane == 62) stamps[62] = rt_entry; if (lane == 63) stamps[63] = (unsigned long long)wall_clock64(); }
#undef PG8_STAMP
#undef PG8_SA
#undef PG8_SB
#undef PG8_STAGE
#undef PG8_LDA
#undef PG8_LDB
#undef PG8_MMA
#undef PG8_WAIT_V
#undef PG8_WAIT_L
#undef PG8_BAR
#undef PG8_SCHED
}
}

namespace cg = cooperative_groups;
typedef unsigned short u16;
typedef pg8::f32x4 f32x4;
typedef pg8::bf16x8 bf16x8;
typedef pg8::u32x4 u32x4;
typedef unsigned u32x2 __attribute__((ext_vector_type(2)));
typedef unsigned long long u64;
#define LAS PG8_LAS

constexpr int NB = 8, T = 4096, D = 1024, M = NB * T;
constexpr int DIN = 6216, NIN = 6400, DFF = 4096;
constexpr float EPSV = 1e-6f;
constexpr size_t MiB = (size_t)1 << 20;
constexpr size_t WS_WT_IN = 0, WS_WT_ORNN = 13 * MiB, WS_WT_OATT = 15 * MiB, WS_WT_OUT = 17 * MiB, WS_WT_FFIN = 19 * MiB, WS_WT_FFOUT = 27 * MiB;
constexpr size_t WS_WT_GATE = 35 * MiB;
constexpr size_t WS_ROWSS = 35 * MiB + 512 * 1024;
constexpr size_t WS_PEND = 36 * MiB, WS_HEND = 38 * MiB;
constexpr size_t WS_IKW = 40 * MiB;
constexpr size_t WS_IKN = 49 * MiB;
constexpr size_t WS_KB = 53 * MiB, WS_VB = 69 * MiB, WS_VT = 85 * MiB;
constexpr size_t WS_MASK = 101 * MiB;
constexpr size_t WS_IQ = 117 * MiB;
constexpr size_t WS_SLAB = 149 * MiB;
constexpr size_t WS_HB = 213 * MiB;
constexpr size_t WS_RX = 277 * MiB;
constexpr size_t WS_GT = 341 * MiB;
constexpr size_t WS_QB = 405 * MiB;
constexpr size_t WS_XW = 40 * MiB;
constexpr size_t WS_HID = 117 * MiB;
constexpr size_t WS_END = 469 * MiB;
constexpr int LDS_BYTES = 131072;

struct Params {
    const float* in[20];
    float* out;
    unsigned char* ws;
    int ph_lo, ph_hi;
};
enum { I_X = 0, I_N1W, I_WIN, I_CONVW, I_CONVB, I_WA, I_BA, I_WX, I_BX, I_LAM, I_QNW, I_KNW, I_IKNW, I_WORNN, I_WOATT, I_GATEB, I_WOUT, I_N2W, I_WFFIN, I_WFFOUT };

__device__ __forceinline__ unsigned pk2(float a, float b) { return pg8::cvt_pk_bf16(a, b); }
__device__ __forceinline__ u16 f2bf(float f) { return (u16)(pk2(f, 0.f) & 0xffffu); }
__device__ __forceinline__ float bflo(unsigned w) { return __uint_as_float(w << 16); }
__device__ __forceinline__ float bfhi(unsigned w) { return __uint_as_float(w & 0xffff0000u); }
__device__ __forceinline__ float bf2f(u16 v) { return __uint_as_float(((unsigned)v) << 16); }
__device__ __forceinline__ float wave_sum(float v) {
#pragma unroll
    for (int o = 32; o; o >>= 1) v += __shfl_xor(v, o);
    return v;
}
__device__ __forceinline__ float sigmoidf_(float v) { return __frcp_rn(1.0f + __expf(-v)); }
__device__ __forceinline__ float gelu_tanh(float x) { const float z = 0.7978845608f * (x + 0.044715f * x * x * x); return x * __frcp_rn(1.0f + __expf(-2.0f * z)); }
__device__ __forceinline__ bf16x8 as_bf16x8(u32x4 w) { union { u32x4 a; bf16x8 b; } c; c.a = w; return c.b; }

template <class MapF>
__device__ __forceinline__ void transpose_w(const float* __restrict__ src, int ld, u16* __restrict__ dst, int K, int Nd, MapF map, int gw, int GW, int lane) {
    const int nblk = Nd >> 6, items = nblk * (K >> 3);
    for (int it = gw; it < items; it += GW) {
        const int nb = it % nblk, kb = it / nblk, n = nb * 64 + lane, k0 = kb * 8, col = map(n);
        float v[8];
#pragma unroll
        for (int j = 0; j < 8; ++j) v[j] = col >= 0 ? src[(size_t)(k0 + j) * ld + col] : 0.f;
        u32x4 w; w.x = pk2(v[0], v[1]); w.y = pk2(v[2], v[3]); w.z = pk2(v[4], v[5]); w.w = pk2(v[6], v[7]);
        *(u32x4*)(dst + (size_t)n * K + k0) = w;
    }
}
struct MapIn { __device__ int operator()(int n) const { return n < 4096 ? n : (n < 6144 ? n + 72 : (n < 6216 ? n - 2048 : -1)); } };
struct MapId { __device__ int operator()(int n) const { return n; } };

__device__ void prepass(const Params& p) {
    const int tid = threadIdx.x, lane = tid & 63, gw = blockIdx.x * 8 + (tid >> 6), GW = gridDim.x * 8;
    unsigned char* ws = p.ws;
    {
        const float* x = p.in[I_X]; const float* nw = p.in[I_N1W]; u16* hb = (u16*)(ws + WS_HB);
        const f32x4 w0 = *(const f32x4*)(nw + 8 * lane), w1 = *(const f32x4*)(nw + 8 * lane + 4), w2 = *(const f32x4*)(nw + 512 + 8 * lane), w3 = *(const f32x4*)(nw + 512 + 8 * lane + 4);
        for (int row = gw; row < M; row += GW) {
            const float* xr = x + (size_t)row * D + 8 * lane;
            f32x4 a0 = *(const f32x4*)xr, a1 = *(const f32x4*)(xr + 4), a2 = *(const f32x4*)(xr + 512), a3 = *(const f32x4*)(xr + 516);
            float ss = 0.f;
#pragma unroll
            for (int j = 0; j < 4; ++j) ss += a0[j] * a0[j] + a1[j] * a1[j] + a2[j] * a2[j] + a3[j] * a3[j];
            ss = wave_sum(ss);
            const float rs = rsqrtf(ss * (1.0f / 1024.0f) + EPSV);
            a0 = a0 * rs * w0; a1 = a1 * rs * w1; a2 = a2 * rs * w2; a3 = a3 * rs * w3;
            u32x4 o0, o1; o0.x = pk2(a0[0], a0[1]); o0.y = pk2(a0[2], a0[3]); o0.z = pk2(a1[0], a1[1]); o0.w = pk2(a1[2], a1[3]);
            o1.x = pk2(a2[0], a2[1]); o1.y = pk2(a2[2], a2[3]); o1.z = pk2(a3[0], a3[1]); o1.w = pk2(a3[2], a3[3]);
            u16* hr = hb + (size_t)row * D + 8 * lane;
            *(u32x4*)hr = o0; *(u32x4*)(hr + 512) = o1;
        }
    }
    transpose_w(p.in[I_WIN], DIN, (u16*)(ws + WS_WT_IN), 1024, NIN, MapIn(), gw, GW, lane);
    transpose_w(p.in[I_WORNN], 1024, (u16*)(ws + WS_WT_ORNN), 1024, 1024, MapId(), gw, GW, lane);
    transpose_w(p.in[I_WOATT], 1024, (u16*)(ws + WS_WT_OATT), 1024, 1024, MapId(), gw, GW, lane);
    transpose_w(p.in[I_WOUT], 1024, (u16*)(ws + WS_WT_OUT), 1024, 1024, MapId(), gw, GW, lane);
    transpose_w(p.in[I_WFFIN], DFF, (u16*)(ws + WS_WT_FFIN), 1024, DFF, MapId(), gw, GW, lane);
    transpose_w(p.in[I_WFFOUT], 1024, (u16*)(ws + WS_WT_FFOUT), DFF, 1024, MapId(), gw, GW, lane);
    {
        u16* wt = (u16*)(ws + WS_WT_GATE);
        const int gt = blockIdx.x * 512 + tid, GT = gridDim.x * 512;
        for (int i = gt; i < 2 * 65536; i += GT) {
            const int which = i >> 16, r = i & 65535, n = r >> 12, e = (r >> 6) & 63, d = r & 63;
            const float* src = which ? p.in[I_WX] : p.in[I_WA];
            wt[i] = f2bf(src[n * 4096 + d * 64 + e]);
        }
        float* rowss = (float*)(ws + WS_ROWSS);
        for (int i = gt; i < M; i += GT) rowss[i] = 0.f;
    }
}

struct EpiG1 {
    static constexpr bool PERM = true, AFTER_DRAIN = false;
    u16 *rx, *gt, *qb, *kb, *vb, *iq, *gb; float* ikw; const float* gate_b;
    __device__ __forceinline__ void operator()(const f32x4 (&acc)[2][2][4][2], const pg8::Unit& u, int wr, int wc, int fr, int fq) const {
        const int row0 = u.pm * 256 + wr * 64 + fr, pn = u.pn, cl = wc * 32 + 8 * fq;
        int mode = 0, ld = 1024; u16* base = rx;
        if (pn < 4) { base = rx + pn * 256; }
        else if (pn < 8) { mode = 1; base = gt + (pn - 4) * 256; }
        else if (pn < 12) { base = qb + (pn - 8) * 256; }
        else if (pn == 12) { base = kb; ld = 256; }
        else if (pn == 13) { base = vb; ld = 256; }
        else if (pn < 16) { base = iq + (pn - 14) * 256; ld = 512; }
        else if (pn < 24) { mode = 2; base = gb + (pn - 16) * 256; ld = 2048; }
        else mode = 3;
        if (mode == 3) {
            if (cl <= 64) {
#pragma unroll
                for (int ai = 0; ai < 2; ++ai)
#pragma unroll
                    for (int m = 0; m < 4; ++m) { float* rp = ikw + (size_t)(row0 + ai * 128 + m * 16) * 72 + cl; *(f32x4*)rp = acc[ai][0][m][0]; *(f32x4*)(rp + 4) = acc[ai][0][m][1]; }
            }
            return;
        }
        f32x4 bv[2][2];
#pragma unroll
        for (int bj = 0; bj < 2; ++bj)
#pragma unroll
            for (int n = 0; n < 2; ++n) bv[bj][n] = (mode == 2) ? *(const f32x4*)(gate_b + (pn - 16) * 256 + bj * 128 + cl + 4 * n) : (f32x4){0.f, 0.f, 0.f, 0.f};
#pragma unroll
        for (int ai = 0; ai < 2; ++ai)
#pragma unroll
            for (int m = 0; m < 4; ++m) {
                u16* rowp = base + (size_t)(row0 + ai * 128 + m * 16) * ld + cl;
#pragma unroll
                for (int bj = 0; bj < 2; ++bj) {
                    f32x4 v0 = acc[ai][bj][m][0], v1 = acc[ai][bj][m][1];
                    if (mode == 1) {
#pragma unroll
                        for (int j = 0; j < 4; ++j) { v0[j] = gelu_tanh(v0[j]); v1[j] = gelu_tanh(v1[j]); }
                    } else if (mode == 2) {
#pragma unroll
                        for (int j = 0; j < 4; ++j) { v0[j] = sigmoidf_(v0[j] + bv[bj][0][j]); v1[j] = sigmoidf_(v1[j] + bv[bj][1][j]); }
                    }
                    u32x4 w; w.x = pk2(v0[0], v0[1]); w.y = pk2(v0[2], v0[3]); w.z = pk2(v1[0], v1[1]); w.w = pk2(v1[2], v1[3]);
                    *(u32x4*)(rowp + bj * 128) = w;
                }
            }
    }
};
struct EpiGate {
    static constexpr bool PERM = true, AFTER_DRAIN = false;
    u16* O; const u16* gsrc; const u16* addsrc;
    __device__ __forceinline__ void operator()(const f32x4 (&acc)[2][2][4][2], const pg8::Unit& u, int wr, int wc, int fr, int fq) const {
        const int row0 = u.pm * 256 + wr * 64 + fr, col0 = u.pn * 256 + wc * 32 + 8 * fq;
#pragma unroll
        for (int ai = 0; ai < 2; ++ai)
#pragma unroll
            for (int m = 0; m < 4; ++m) {
                const size_t row = (size_t)(row0 + ai * 128 + m * 16);
#pragma unroll
                for (int bj = 0; bj < 2; ++bj) {
                    const int col = col0 + bj * 128;
                    const u32x4 gw = *(const u32x4*)(gsrc + row * 2048 + col);
                    u32x4 aw = {0u, 0u, 0u, 0u};
                    if (addsrc) aw = *(const u32x4*)(addsrc + row * 1024 + col);
                    const f32x4 v0 = acc[ai][bj][m][0], v1 = acc[ai][bj][m][1];
                    u32x4 w;
                    w.x = pk2(bflo(aw.x) + bflo(gw.x) * v0[0], bfhi(aw.x) + bfhi(gw.x) * v0[1]);
                    w.y = pk2(bflo(aw.y) + bflo(gw.y) * v0[2], bfhi(aw.y) + bfhi(gw.y) * v0[3]);
                    w.z = pk2(bflo(aw.z) + bflo(gw.z) * v1[0], bfhi(aw.z) + bfhi(gw.z) * v1[1]);
                    w.w = pk2(bflo(aw.w) + bflo(gw.w) * v1[2], bfhi(aw.w) + bfhi(gw.w) * v1[3]);
                    *(u32x4*)(O + row * 1024 + col) = w;
                }
            }
    }
};
struct EpiRes1 {
    static constexpr bool PERM = true, AFTER_DRAIN = false;
    const float* x; float* out; u16* xw; const float* n2w; float* rowss;
    __device__ __forceinline__ void operator()(const f32x4 (&acc)[2][2][4][2], const pg8::Unit& u, int wr, int wc, int fr, int fq) const {
        const int row0 = u.pm * 256 + wr * 64 + fr, col0 = u.pn * 256 + wc * 32 + 8 * fq;
        f32x4 nw[2][2];
#pragma unroll
        for (int bj = 0; bj < 2; ++bj)
#pragma unroll
            for (int n = 0; n < 2; ++n) nw[bj][n] = *(const f32x4*)(n2w + col0 + bj * 128 + 4 * n);
#pragma unroll
        for (int ai = 0; ai < 2; ++ai)
#pragma unroll
            for (int m = 0; m < 4; ++m) {
                const size_t row = (size_t)(row0 + ai * 128 + m * 16);
                float ss = 0.f;
#pragma unroll
                for (int bj = 0; bj < 2; ++bj) {
                    const int col = col0 + bj * 128;
                    const float* xp = x + row * 1024 + col;
                    f32x4 v0 = *(const f32x4*)xp + acc[ai][bj][m][0], v1 = *(const f32x4*)(xp + 4) + acc[ai][bj][m][1];
                    float* op = out + row * 1024 + col;
                    *(f32x4*)op = v0; *(f32x4*)(op + 4) = v1;
#pragma unroll
                    for (int j = 0; j < 4; ++j) ss += v0[j] * v0[j] + v1[j] * v1[j];
                    v0 = v0 * nw[bj][0]; v1 = v1 * nw[bj][1];
                    u32x4 w; w.x = pk2(v0[0], v0[1]); w.y = pk2(v0[2], v0[3]); w.z = pk2(v1[0], v1[1]); w.w = pk2(v1[2], v1[3]);
                    *(u32x4*)(xw + row * 1024 + col) = w;
                }
                ss += __shfl_xor(ss, 16); ss += __shfl_xor(ss, 32);
                if (fq == 0) atomicAdd(rowss + row, ss);
            }
    }
};
struct EpiFF1 {
    static constexpr bool PERM = true, AFTER_DRAIN = false;
    u16* hid; const float* rowss;
    __device__ __forceinline__ void operator()(const f32x4 (&acc)[2][2][4][2], const pg8::Unit& u, int wr, int wc, int fr, int fq) const {
        const int row0 = u.pm * 256 + wr * 64 + fr, col0 = u.pn * 256 + wc * 32 + 8 * fq;
#pragma unroll
        for (int ai = 0; ai < 2; ++ai)
#pragma unroll
            for (int m = 0; m < 4; ++m) {
                const size_t row = (size_t)(row0 + ai * 128 + m * 16);
                const float rs = rsqrtf(rowss[row] * (1.0f / 1024.0f) + EPSV);
#pragma unroll
                for (int bj = 0; bj < 2; ++bj) {
                    f32x4 v0 = acc[ai][bj][m][0] * rs, v1 = acc[ai][bj][m][1] * rs;
#pragma unroll
                    for (int j = 0; j < 4; ++j) { const float a = fmaxf(v0[j], 0.f), b = fmaxf(v1[j], 0.f); v0[j] = a * a; v1[j] = b * b; }
                    u32x4 w; w.x = pk2(v0[0], v0[1]); w.y = pk2(v0[2], v0[3]); w.z = pk2(v1[0], v1[1]); w.w = pk2(v1[2], v1[3]);
                    *(u32x4*)(hid + row * DFF + col0 + bj * 128) = w;
                }
            }
    }
};
struct EpiRes2 {
    static constexpr bool PERM = true, AFTER_DRAIN = false;
    float* out;
    __device__ __forceinline__ void operator()(const f32x4 (&acc)[2][2][4][2], const pg8::Unit& u, int wr, int wc, int fr, int fq) const {
        const int row0 = u.pm * 256 + wr * 64 + fr, col0 = u.pn * 256 + wc * 32 + 8 * fq;
#pragma unroll
        for (int ai = 0; ai < 2; ++ai)
#pragma unroll
            for (int m = 0; m < 4; ++m) {
                const size_t row = (size_t)(row0 + ai * 128 + m * 16);
#pragma unroll
                for (int bj = 0; bj < 2; ++bj) {
                    float* op = out + row * 1024 + col0 + bj * 128;
                    *(f32x4*)op = *(const f32x4*)op + acc[ai][bj][m][0];
                    *(f32x4*)(op + 4) = *(const f32x4*)(op + 4) + acc[ai][bj][m][1];
                }
            }
    }
};
template <class Epi>
__device__ __forceinline__ void run_gemm(LAS unsigned char* L, const u16* A, const u16* Bt, int N, int K, const Epi& E) {
    pg8::Gemm g; g.A = A; g.Bt = Bt; g.M = M; g.N = N; g.K = K;
    pg8::StaticOrder S; S.init(M, N, (int)gridDim.x, (int)blockIdx.x);
    pg8::gemm_phase<Epi, pg8::StaticOrder, false>(L, g, S, E, nullptr);
}

__device__ void norm_phase(const Params& p) {
    const int tid = threadIdx.x, lane = tid & 63, gw = blockIdx.x * 8 + (tid >> 6), GW = gridDim.x * 8;
    unsigned char* ws = p.ws;
    u16* qb = (u16*)(ws + WS_QB); u16* kb = (u16*)(ws + WS_KB); const u16* vb = (const u16*)(ws + WS_VB); u16* vT = (u16*)(ws + WS_VT);
    const float* ikw = (const float*)(ws + WS_IKW); u16* ikn = (u16*)(ws + WS_IKN);
    const float* qnw = p.in[I_QNW] + (lane & 3) * 16; const float* knw = p.in[I_KNW] + (lane & 15) * 4; const float iknw = p.in[I_IKNW][lane];
    f32x4 qw4[4]; for (int i = 0; i < 4; ++i) qw4[i] = *(const f32x4*)(qnw + 4 * i);
    const f32x4 kw4 = *(const f32x4*)knw;
    for (int row = gw; row < M; row += GW) {
        {
            u16* qr = qb + (size_t)row * 1024 + 16 * lane;
            u32x4 w0 = *(const u32x4*)qr, w1 = *(const u32x4*)(qr + 8);
            float v[16];
            v[0] = bflo(w0.x); v[1] = bfhi(w0.x); v[2] = bflo(w0.y); v[3] = bfhi(w0.y); v[4] = bflo(w0.z); v[5] = bfhi(w0.z); v[6] = bflo(w0.w); v[7] = bfhi(w0.w);
            v[8] = bflo(w1.x); v[9] = bfhi(w1.x); v[10] = bflo(w1.y); v[11] = bfhi(w1.y); v[12] = bflo(w1.z); v[13] = bfhi(w1.z); v[14] = bflo(w1.w); v[15] = bfhi(w1.w);
            float ss = 0.f;
#pragma unroll
            for (int j = 0; j < 16; ++j) ss += v[j] * v[j];
            ss += __shfl_xor(ss, 1); ss += __shfl_xor(ss, 2);
            const float rs = rsqrtf(ss * (1.0f / 64.0f) + EPSV);
#pragma unroll
            for (int j = 0; j < 16; ++j) v[j] = v[j] * rs * qw4[j >> 2][j & 3];
            w0.x = pk2(v[0], v[1]); w0.y = pk2(v[2], v[3]); w0.z = pk2(v[4], v[5]); w0.w = pk2(v[6], v[7]);
            w1.x = pk2(v[8], v[9]); w1.y = pk2(v[10], v[11]); w1.z = pk2(v[12], v[13]); w1.w = pk2(v[14], v[15]);
            *(u32x4*)qr = w0; *(u32x4*)(qr + 8) = w1;
        }
        {
            u16* kr = kb + (size_t)row * 256 + 4 * lane;
            u32x2 w = *(const u32x2*)kr;
            float v0 = bflo(w.x), v1 = bfhi(w.x), v2 = bflo(w.y), v3 = bfhi(w.y);
            float ss = v0 * v0 + v1 * v1 + v2 * v2 + v3 * v3;
            ss += __shfl_xor(ss, 1); ss += __shfl_xor(ss, 2); ss += __shfl_xor(ss, 4); ss += __shfl_xor(ss, 8);
            const float rs = rsqrtf(ss * (1.0f / 64.0f) + EPSV);
            w.x = pk2(v0 * rs * kw4[0], v1 * rs * kw4[1]); w.y = pk2(v2 * rs * kw4[2], v3 * rs * kw4[3]);
            *(u32x2*)kr = w;
        }
        {
            const float iv = ikw[(size_t)row * 72 + lane];
            const float ss = wave_sum(iv * iv);
            ikn[(size_t)row * 64 + lane] = f2bf(iv * rsqrtf(ss * (1.0f / 64.0f) + EPSV) * iknw);
        }
    }
    for (int it = gw; it < NB * 4 * (T / 8); it += GW) {
        const int tg = it & 511, g = (it >> 9) & 3, b = it >> 11, t0 = tg * 8;
        const u16* src = vb + (size_t)(b * T + t0) * 256 + g * 64 + lane;
        u16 v[8];
#pragma unroll
        for (int j = 0; j < 8; ++j) v[j] = src[j * 256];
        u32x4 w; w.x = v[0] | ((unsigned)v[1] << 16); w.y = v[2] | ((unsigned)v[3] << 16); w.z = v[4] | ((unsigned)v[5] << 16); w.w = v[6] | ((unsigned)v[7] << 16);
        *(u32x4*)(vT + ((size_t)((b * 4 + g) * 64 + lane)) * T + t0) = w;
    }
}

template <int MODE>
__device__ void rnn_phase(const Params& p, LAS unsigned char* L) {
    const int tid = threadIdx.x, hb = tid >> 8, t2 = tid & 255, lane = tid & 63, wv = t2 >> 6, fr = lane & 15, fq = lane >> 4;
    const int ch = t2 & 63, qt = t2 >> 6;
    LAS unsigned char* Lh = L + hb * 55296;
    LAS float* xs = (LAS float*)Lh;
    LAS float* as = (LAS float*)Lh;
    LAS float* xcs = (LAS float*)(Lh + 17408);
    LAS float* us = (LAS float*)(Lh + 34816);
    LAS float* part = (LAS float*)(Lh + 52224);
    LAS float* cin = (LAS float*)(Lh + 54272);
    unsigned char* ws = p.ws;
    const u16* rx = (const u16*)(ws + WS_RX); u16* gt = (u16*)(ws + WS_GT);
    float* PEND = (float*)(ws + WS_PEND); float* HEND = (float*)(ws + WS_HEND);
    const u16* wgT = (const u16*)(ws + WS_WT_GATE);
    for (int it = blockIdx.x; it < 256; it += gridDim.x) {
        const int item = it * 2 + hb, b = item >> 6, n = (item >> 2) & 15, seg = item & 3, gch = n * 64 + ch;
        const float cw0 = p.in[I_CONVW][gch], cw1 = p.in[I_CONVW][1024 + gch], cw2 = p.in[I_CONVW][2048 + gch], cw3 = p.in[I_CONVW][3072 + gch], cb = p.in[I_CONVB][gch];
        bf16x8 waf[4][2], wxf[4][2];
#pragma unroll
        for (int m = 0; m < 4; ++m)
#pragma unroll
            for (int ks = 0; ks < 2; ++ks) {
                const size_t o = (size_t)((n * 64 + 16 * m + fr) * 64 + 32 * ks + 8 * fq);
                waf[m][ks] = *(const bf16x8*)(wgT + o); wxf[m][ks] = *(const bf16x8*)(wgT + 65536 + o);
            }
        if (MODE == 1 && qt == 0) {
            float h = 0.f;
            for (int cc = 0; cc < seg * 16; ++cc) { const size_t o = (size_t)((b * 64 + cc) * 1024 + gch); h = PEND[o] * h + HEND[o]; }
            cin[ch] = h;
        }
        for (int cc = 0; cc < 16; ++cc) {
            const int c = seg * 16 + cc, t0 = c * 64;
#pragma unroll
            for (int i = 0; i < 3; ++i) {
                const int rr = (t2 >> 3) + 32 * i, cg8 = t2 & 7;
                if (rr < 67) {
                    const int tt = t0 - 3 + rr;
                    u32x4 w = {0u, 0u, 0u, 0u};
                    if (tt >= 0) w = *(const u32x4*)(rx + (size_t)(b * T + tt) * 1024 + n * 64 + cg8 * 8);
                    f32x4 lo = {bflo(w.x), bfhi(w.x), bflo(w.y), bfhi(w.y)}, hi = {bflo(w.z), bfhi(w.z), bflo(w.w), bfhi(w.w)};
                    *(LAS f32x4*)(xs + rr * 64 + cg8 * 8) = lo; *(LAS f32x4*)(xs + rr * 64 + cg8 * 8 + 4) = hi;
                }
            }
            __syncthreads();
            {
                float x0 = xs[(16 * qt) * 64 + ch], x1 = xs[(16 * qt + 1) * 64 + ch], x2 = xs[(16 * qt + 2) * 64 + ch];
#pragma unroll
                for (int j = 0; j < 16; ++j) {
                    const int tt = 16 * qt + j;
                    const float x3 = xs[(tt + 3) * 64 + ch];
                    xcs[tt * 68 + ch] = cb + cw0 * x0 + cw1 * x1 + cw2 * x2 + cw3 * x3;
                    x0 = x1; x1 = x2; x2 = x3;
                }
            }
            __syncthreads();
            {
                const int trow = 16 * wv + fr;
                bf16x8 yf[2];
#pragma unroll
                for (int ks = 0; ks < 2; ++ks) {
                    const f32x4 a = *(const LAS f32x4*)(xcs + trow * 68 + 32 * ks + 8 * fq), bq = *(const LAS f32x4*)(xcs + trow * 68 + 32 * ks + 8 * fq + 4);
                    u32x4 w; w.x = pk2(a[0], a[1]); w.y = pk2(a[2], a[3]); w.z = pk2(bq[0], bq[1]); w.w = pk2(bq[2], bq[3]);
                    yf[ks] = as_bf16x8(w);
                }
#pragma unroll
                for (int m = 0; m < 4; ++m) {
                    f32x4 ga = {0.f, 0.f, 0.f, 0.f}, gx = {0.f, 0.f, 0.f, 0.f};
#pragma unroll
                    for (int ks = 0; ks < 2; ++ks) { ga = __builtin_amdgcn_mfma_f32_16x16x32_bf16(waf[m][ks], yf[ks], ga, 0, 0, 0); gx = __builtin_amdgcn_mfma_f32_16x16x32_bf16(wxf[m][ks], yf[ks], gx, 0, 0, 0); }
                    const int e0 = 16 * m + 4 * fq;
                    const f32x4 ba4 = *(const f32x4*)(p.in[I_BA] + n * 64 + e0), bx4 = *(const f32x4*)(p.in[I_BX] + n * 64 + e0), lam4 = *(const f32x4*)(p.in[I_LAM] + n * 64 + e0);
                    const f32x4 xc4 = *(const LAS f32x4*)(xcs + trow * 68 + e0);
                    f32x4 a4, u4;
#pragma unroll
                    for (int r = 0; r < 4; ++r) {
                        const float ra = sigmoidf_(ga[r] + ba4[r]), ri = sigmoidf_(gx[r] + bx4[r]);
                        const float la = -8.0f * ra * log1pf(__expf(-lam4[r]));
                        a4[r] = __expf(la);
                        u4[r] = sqrtf(-expm1f(2.0f * la)) * (ri * xc4[r]);
                    }
                    *(LAS f32x4*)(as + trow * 68 + e0) = a4; *(LAS f32x4*)(us + trow * 68 + e0) = u4;
                }
            }
            __syncthreads();
            {
                float P = 1.f, H = 0.f;
#pragma unroll
                for (int j = 0; j < 16; ++j) { const int tt = 16 * qt + j; const float a = as[tt * 68 + ch]; H = a * H + us[tt * 68 + ch]; P *= a; }
                part[(qt * 64 + ch) * 2] = P; part[(qt * 64 + ch) * 2 + 1] = H;
            }
            __syncthreads();
            if (MODE == 0) {
                if (qt == 0) {
                    float Pt = 1.f, Ht = 0.f;
#pragma unroll
                    for (int q = 0; q < 4; ++q) { const float Pq = part[(q * 64 + ch) * 2], Hq = part[(q * 64 + ch) * 2 + 1]; Ht = Pq * Ht + Hq; Pt *= Pq; }
                    const size_t o = (size_t)((b * 64 + c) * 1024 + gch);
                    PEND[o] = Pt; HEND[o] = Ht;
                }
            } else {
                float h = cin[(c & 1) * 64 + ch], hs = 0.f;
#pragma unroll
                for (int q = 0; q < 4; ++q) { if (q == qt) hs = h; const float Pq = part[(q * 64 + ch) * 2], Hq = part[(q * 64 + ch) * 2 + 1]; h = Pq * h + Hq; }
                if (qt == 0) cin[((c + 1) & 1) * 64 + ch] = h;
                h = hs;
                u16* gp = gt + (size_t)(b * T + t0 + 16 * qt) * 1024 + gch;
#pragma unroll
                for (int j = 0; j < 16; ++j) {
                    const int tt = 16 * qt + j;
                    h = as[tt * 68 + ch] * h + us[tt * 68 + ch];
                    gp[(size_t)j * 1024] = f2bf(h * bf2f(gp[(size_t)j * 1024]));
                }
            }
            __syncthreads();
        }
    }
}

__device__ void indexer_phase(const Params& p) {
    const int tid = threadIdx.x, wid = tid >> 6, lane = tid & 63, fr = lane & 15, fq = lane >> 4, G = gridDim.x;
    unsigned char* ws = p.ws;
    float* slab = (float*)(ws + WS_SLAB) + (size_t)blockIdx.x * 16 * 4096;
    const u16* iq = (const u16*)(ws + WS_IQ); const u16* ikn = (const u16*)(ws + WS_IKN); const float* ikw = (const float*)(ws + WS_IKW);
    u64* maskT = (u64*)(ws + WS_MASK);
    const float idx_scale = 0.04419417382f;
    for (int k = 0; k * G < 1920; ++k) {
        const int u = k * G + ((k & 1) ? (G - 1 - (int)blockIdx.x) : (int)blockIdx.x);
        if (u >= 1920) continue;
        const int c = 63 - (u >> 5), b = (u >> 2) & 7, qg = u & 3, tok0 = b * T + 64 * c + 16 * qg;
        bf16x8 yq[8][2]; float wq[8];
#pragma unroll
        for (int h = 0; h < 8; ++h) {
#pragma unroll
            for (int ks = 0; ks < 2; ++ks) yq[h][ks] = *(const bf16x8*)(iq + (size_t)(tok0 + fr) * 512 + h * 64 + 32 * ks + 8 * fq);
            wq[h] = ikw[(size_t)(tok0 + fr) * 72 + 64 + h];
        }
        const int ntile = 4 * (c + 1);
        for (int tile = wid; tile < ntile; tile += 16) {
            const bool two = (tile + 8) < ntile;
            const u16* kp0 = ikn + (size_t)(b * T + 16 * tile + fr) * 64 + 8 * fq;
            const u16* kp1 = kp0 + (two ? 8 * 16 * 64 : 0);
            const bf16x8 x00 = *(const bf16x8*)kp0, x01 = *(const bf16x8*)(kp0 + 32), x10 = *(const bf16x8*)kp1, x11 = *(const bf16x8*)(kp1 + 32);
            f32x4 s0 = {0.f, 0.f, 0.f, 0.f}, s1 = {0.f, 0.f, 0.f, 0.f};
#pragma unroll
            for (int h = 0; h < 8; ++h) {
                f32x4 a0 = {0.f, 0.f, 0.f, 0.f}, a1 = {0.f, 0.f, 0.f, 0.f};
                a0 = __builtin_amdgcn_mfma_f32_16x16x32_bf16(x00, yq[h][0], a0, 0, 0, 0); a0 = __builtin_amdgcn_mfma_f32_16x16x32_bf16(x01, yq[h][1], a0, 0, 0, 0);
                a1 = __builtin_amdgcn_mfma_f32_16x16x32_bf16(x10, yq[h][0], a1, 0, 0, 0); a1 = __builtin_amdgcn_mfma_f32_16x16x32_bf16(x11, yq[h][1], a1, 0, 0, 0);
#pragma unroll
                for (int r = 0; r < 4; ++r) { s0[r] += wq[h] * fmaxf(a0[r], 0.f); s1[r] += wq[h] * fmaxf(a1[r], 0.f); }
            }
            *(f32x4*)(slab + fr * 4096 + 16 * tile + 4 * fq) = s0 * idx_scale;
            if (two) *(f32x4*)(slab + fr * 4096 + 16 * (tile + 8) + 4 * fq) = s1 * idx_scale;
        }
        __threadfence(); __syncthreads(); __threadfence();
        const int R = c + 1;
#pragma unroll 1
        for (int qi = 0; qi < 2; ++qi) {
            const int q = 2 * wid + qi;
            const float* row = slab + q * 4096 + lane;
            unsigned key[64];
#pragma unroll
            for (int r = 0; r < 64; ++r) {
                key[r] = 0u;
                if (r < R) { const unsigned bts = __float_as_uint(row[64 * r] + 0.0f); key[r] = (bts & 0x80000000u) ? ~bts : (bts | 0x80000000u); }
            }
            unsigned thr = 0u; bool exact = false;
#pragma unroll 1
            for (int bit = 31; bit >= 0; --bit) {
                const unsigned cand = thr | (1u << bit);
                int cnt = 0;
#pragma unroll
                for (int gI = 0; gI < 4; ++gI)
                    if (R > 16 * gI) {
#pragma unroll
                        for (int r = 16 * gI; r < 16 * gI + 16; ++r) cnt += __popcll(__ballot(key[r] >= cand));
                    }
                if (cnt >= 256) { thr = cand; if (cnt == 256) { exact = true; break; } }
            }
            int need = 1 << 30;
            if (!exact) {
                int cgt = 0;
#pragma unroll
                for (int r = 0; r < 64; ++r) cgt += __popcll(__ballot(key[r] > thr));
                need = 256 - cgt;
            }
            const u64 lt = (1ull << lane) - 1ull;
            u64 myword = 0ull;
#pragma unroll
            for (int r = 0; r < 64; ++r) {
                const bool iseq = key[r] == thr;
                const u64 eq = __ballot(iseq);
                const int pre = __popcll(eq & lt);
                const u64 sel = __ballot(key[r] > thr || (iseq && pre < need));
                if (need < (1 << 29)) need -= __popcll(eq);
                if (lane == r) myword = sel;
            }
            if (lane < R) maskT[(((size_t)(b * 64 + c)) * 64 + lane) * 64 + 16 * qg + q] = myword;
        }
        __syncthreads();
    }
}

__device__ void attn_phase(const Params& p, LAS unsigned char* L) {
    const int tid = threadIdx.x, wid = tid >> 6, lane = tid & 63, fr = lane & 15, fq = lane >> 4, G = gridDim.x;
    const int hql = wid >> 1, half = wid & 1;
    unsigned char* ws = p.ws;
    u16* qb = (u16*)(ws + WS_QB); const u16* kb = (const u16*)(ws + WS_KB); const u16* vT = (const u16*)(ws + WS_VT);
    const u64* maskT = (const u64*)(ws + WS_MASK);
    const float sc = 0.18033688011f;
    const int skey = tid >> 3, sdg = tid & 7;
    for (int k = 0; k * G < 2048; ++k) {
        const int u = k * G + ((k & 1) ? (G - 1 - (int)blockIdx.x) : (int)blockIdx.x);
        if (u >= 2048) continue;
        const int c = 63 - (u >> 5), b = (u >> 2) & 7, g = u & 3, hq = g * 4 + hql;
        const int tokq = b * T + 64 * c + 32 * half;
        bf16x8 qf[2][2];
#pragma unroll
        for (int n = 0; n < 2; ++n)
#pragma unroll
            for (int ks = 0; ks < 2; ++ks) qf[n][ks] = *(const bf16x8*)(qb + (size_t)(tokq + 16 * n + fr) * 1024 + hq * 64 + 32 * ks + 8 * fq);
        f32x4 O[4][2];
#pragma unroll
        for (int md = 0; md < 4; ++md)
#pragma unroll
            for (int n = 0; n < 2; ++n) O[md][n] = (f32x4){0.f, 0.f, 0.f, 0.f};
        float mrun[2] = {-1e30f, -1e30f}, lrun[2] = {0.f, 0.f};
        const u16* kg = kb + (size_t)(b * T + skey) * 256 + g * 64 + sdg * 8;
        const u16* vg = vT + ((size_t)((b * 4 + g) * 64 + skey)) * T + sdg * 8;
        u32x4 kreg = *(const u32x4*)kg, vreg = *(const u32x4*)vg;
        *(LAS u32x4*)(L + (skey * 72 + sdg * 8) * 2) = kreg; *(LAS u32x4*)(L + 9216 + (skey * 72 + sdg * 8) * 2) = vreg;
        __syncthreads();
        for (int kt = 0; kt <= c; ++kt) {
            LAS unsigned char* Kc = L + (kt & 1) * 18432; LAS unsigned char* Vc = Kc + 9216;
            if (kt < c) { kreg = *(const u32x4*)(kg + (size_t)(kt + 1) * 64 * 256); vreg = *(const u32x4*)(vg + (kt + 1) * 64); }
            u64 mw[2] = {~0ull, ~0ull};
            if (c >= 4) {
#pragma unroll
                for (int n = 0; n < 2; ++n) mw[n] = maskT[(((size_t)(b * 64 + c)) * 64 + kt) * 64 + 32 * half + 16 * n + fr];
            }
            f32x4 S[4][2];
#pragma unroll
            for (int m = 0; m < 4; ++m)
#pragma unroll
                for (int n = 0; n < 2; ++n) S[m][n] = (f32x4){0.f, 0.f, 0.f, 0.f};
#pragma unroll
            for (int ks = 0; ks < 2; ++ks)
#pragma unroll
                for (int m = 0; m < 4; ++m) {
                    const bf16x8 kf = *(const LAS bf16x8*)(Kc + ((16 * m + fr) * 72 + 32 * ks + 8 * fq) * 2);
#pragma unroll
                    for (int n = 0; n < 2; ++n) S[m][n] = __builtin_amdgcn_mfma_f32_16x16x32_bf16(kf, qf[n][ks], S[m][n], 0, 0, 0);
                }
#pragma unroll
            for (int n = 0; n < 2; ++n) {
                float tmax = -1e30f;
#pragma unroll
                for (int m = 0; m < 4; ++m) {
                    const unsigned bits = (unsigned)(mw[n] >> (16 * m + 4 * fq)) & 15u;
#pragma unroll
                    for (int r = 0; r < 4; ++r) { const float s = ((bits >> r) & 1u) ? S[m][n][r] * sc : -1e30f; S[m][n][r] = s; tmax = fmaxf(tmax, s); }
                }
                tmax = fmaxf(tmax, __shfl_xor(tmax, 16)); tmax = fmaxf(tmax, __shfl_xor(tmax, 32));
                const float mnew = fmaxf(mrun[n], tmax), alpha = __builtin_amdgcn_exp2f(mrun[n] - mnew);
                mrun[n] = mnew;
                float psum = 0.f;
#pragma unroll
                for (int m = 0; m < 4; ++m)
#pragma unroll
                    for (int r = 0; r < 4; ++r) { const float pv = __builtin_amdgcn_exp2f(S[m][n][r] - mnew); S[m][n][r] = pv; psum += pv; }
                lrun[n] = lrun[n] * alpha + psum;
#pragma unroll
                for (int md = 0; md < 4; ++md) O[md][n] = O[md][n] * alpha;
            }
#pragma unroll
            for (int kk = 0; kk < 2; ++kk) {
                bf16x8 pf[2];
#pragma unroll
                for (int n = 0; n < 2; ++n) {
                    u32x4 w; w.x = pk2(S[2 * kk][n][0], S[2 * kk][n][1]); w.y = pk2(S[2 * kk][n][2], S[2 * kk][n][3]);
                    w.z = pk2(S[2 * kk + 1][n][0], S[2 * kk + 1][n][1]); w.w = pk2(S[2 * kk + 1][n][2], S[2 * kk + 1][n][3]);
                    pf[n] = as_bf16x8(w);
                }
#pragma unroll
                for (int md = 0; md < 4; ++md) {
                    const u32x2 v0 = *(const LAS u32x2*)(Vc + ((16 * md + fr) * 72 + 32 * kk + 4 * fq) * 2), v1 = *(const LAS u32x2*)(Vc + ((16 * md + fr) * 72 + 32 * kk + 16 + 4 * fq) * 2);
                    u32x4 w; w.x = v0.x; w.y = v0.y; w.z = v1.x; w.w = v1.y;
                    const bf16x8 vf = as_bf16x8(w);
#pragma unroll
                    for (int n = 0; n < 2; ++n) O[md][n] = __builtin_amdgcn_mfma_f32_16x16x32_bf16(vf, pf[n], O[md][n], 0, 0, 0);
                }
            }
            if (kt < c) {
                LAS unsigned char* Kn = L + ((kt + 1) & 1) * 18432;
                *(LAS u32x4*)(Kn + (skey * 72 + sdg * 8) * 2) = kreg; *(LAS u32x4*)(Kn + 9216 + (skey * 72 + sdg * 8) * 2) = vreg;
            }
            __syncthreads();
        }
#pragma unroll
        for (int n = 0; n < 2; ++n) {
            float l = lrun[n]; l += __shfl_xor(l, 16); l += __shfl_xor(l, 32);
            const float inv = 1.0f / l;
#pragma unroll
            for (int md = 0; md < 4; ++md) {
                const f32x4 o = O[md][n] * inv;
                u32x2 w; w.x = pk2(o[0], o[1]); w.y = pk2(o[2], o[3]);
                *(u32x2*)(qb + (size_t)(tokq + 16 * n + fr) * 1024 + hq * 64 + 16 * md + 4 * fq) = w;
            }
        }
    }
}

__global__ void __launch_bounds__(512, 2) fwd_megakernel(Params p) {
    extern __shared__ __attribute__((aligned(16))) unsigned char shm[];
    LAS unsigned char* L = (LAS unsigned char*)shm;
    cg::grid_group grid = cg::this_grid();
    unsigned char* ws = p.ws;
    u16* gb = (u16*)p.out;
#define PHASE(i) if (p.ph_lo <= (i) && (i) < p.ph_hi)
#define SEAM(i) if (p.ph_lo <= (i) && (i) + 1 < p.ph_hi) grid.sync()
    PHASE(0) prepass(p);
    SEAM(0);
    PHASE(1) {
        EpiG1 E; E.rx = (u16*)(ws + WS_RX); E.gt = (u16*)(ws + WS_GT); E.qb = (u16*)(ws + WS_QB); E.kb = (u16*)(ws + WS_KB); E.vb = (u16*)(ws + WS_VB); E.iq = (u16*)(ws + WS_IQ); E.gb = gb;
        E.ikw = (float*)(ws + WS_IKW); E.gate_b = p.in[I_GATEB];
        run_gemm(L, (const u16*)(ws + WS_HB), (const u16*)(ws + WS_WT_IN), NIN, 1024, E);
    }
    SEAM(1);
    PHASE(2) { rnn_phase<0>(p, L); norm_phase(p); }
    SEAM(2);
    PHASE(3) { rnn_phase<1>(p, L); indexer_phase(p); }
    SEAM(3);
    PHASE(4) {
        attn_phase(p, L);
        EpiGate E; E.O = (u16*)(ws + WS_HB); E.gsrc = gb; E.addsrc = nullptr;
        run_gemm(L, (const u16*)(ws + WS_GT), (const u16*)(ws + WS_WT_ORNN), 1024, 1024, E);
    }
    SEAM(4);
    PHASE(5) {
        EpiGate E; E.O = (u16*)(ws + WS_RX); E.gsrc = gb + 1024; E.addsrc = (const u16*)(ws + WS_HB);
        run_gemm(L, (const u16*)(ws + WS_QB), (const u16*)(ws + WS_WT_OATT), 1024, 1024, E);
    }
    SEAM(5);
    PHASE(6) {
        EpiRes1 E; E.x = p.in[I_X]; E.out = p.out; E.xw = (u16*)(ws + WS_XW); E.n2w = p.in[I_N2W]; E.rowss = (float*)(ws + WS_ROWSS);
        run_gemm(L, (const u16*)(ws + WS_RX), (const u16*)(ws + WS_WT_OUT), 1024, 1024, E);
    }
    SEAM(6);
    PHASE(7) {
        EpiFF1 E; E.hid = (u16*)(ws + WS_HID); E.rowss = (const float*)(ws + WS_ROWSS);
        run_gemm(L, (const u16*)(ws + WS_XW), (const u16*)(ws + WS_WT_FFIN), DFF, 1024, E);
    }
    SEAM(7);
    PHASE(8) {
        EpiRes2 E; E.out = p.out;
        run_gemm(L, (const u16*)(ws + WS_HID), (const u16*)(ws + WS_WT_FFOUT), 1024, DFF, E);
    }
#undef PHASE
#undef SEAM
}

extern "C" void kernel_launch(void* const* d_in, const int* in_sizes, int n_in, void* d_out, int out_size, void* d_ws, size_t ws_size, hipStream_t stream) {
    static int grid_blocks = 0;
    if (grid_blocks == 0) {
        if (n_in != 20 || out_size != M * D || ws_size < WS_END) { fprintf(stderr, "kernel_launch: unexpected shapes (n_in %d out %d ws %zu)\n", n_in, out_size, ws_size); grid_blocks = -1; return; }
        int dev = 0, cus = 0, per_cu = 0;
        (void)hipGetDevice(&dev);
        (void)hipDeviceGetAttribute(&cus, hipDeviceAttributeMultiprocessorCount, dev);
        (void)hipFuncSetAttribute((const void*)fwd_megakernel, hipFuncAttributeMaxDynamicSharedMemorySize, LDS_BYTES);
        (void)hipOccupancyMaxActiveBlocksPerMultiprocessor(&per_cu, (const void*)fwd_megakernel, 512, LDS_BYTES);
        if (per_cu < 1) { fprintf(stderr, "kernel_launch: occupancy query says %d blocks per CU\n", per_cu); per_cu = 1; }
        grid_blocks = cus;
        fprintf(stderr, "kernel_launch: cus %d per_cu %d grid %d\n", cus, per_cu, grid_blocks);
    }
    if (grid_blocks < 0) return;
    Params p{};
    for (int i = 0; i < 20; ++i) p.in[i] = (const float*)d_in[i];
    p.out = (float*)d_out; p.ws = (unsigned char*)d_ws; p.ph_lo = 0; p.ph_hi = 9;
    void* args[] = {&p};
    hipError_t e = hipLaunchCooperativeKernel((const void*)fwd_megakernel, dim3(grid_blocks), dim3(512), args, LDS_BYTES, stream);
    if (e != hipSuccess) fprintf(stderr, "cooperative launch failed: %s (grid %d)\n", hipGetErrorString(e), grid_blocks);
}
```

```cpp
#include <hip/hip_runtime.h>
#include <hip/hip_cooperative_groups.h>
#include <cstdio>
#define PROBE_DBL 0
namespace pg8 {
#define PG8_LAS __attribute__((address_space(3)))
typedef unsigned short bf16_t;
typedef short bf16x8 __attribute__((ext_vector_type(8)));
typedef float f32x4 __attribute__((ext_vector_type(4)));
typedef unsigned u32x4 __attribute__((ext_vector_type(4)));
constexpr int BM = 256, BK = 64, HALF = 128, HTB = HALF * BK * 2  , STAGE_BYTES = 8 * HTB, NXCD = 8, WGM = 8;

__host__ __device__ __forceinline__ int lds_byte(int r, int c) { const int st = (r >> 4) * 2 + (c >> 5), rr = r & 15, cc = c & 31, ob = rr * 64 + cc * 2; return st * 1024 + (ob ^ (((ob >> 9) & 1) << 5)); }
__host__ __device__ __forceinline__ void stage_rc(int b, int& R, int& C) { const int st = b / 1024, sb = b % 1024, swz = sb ^ (((sb >> 9) & 1) << 5); R = (st >> 1) * 16 + swz / 64; C = (st & 1) * 32 + (swz % 64) / 2; }
__host__ __device__ __forceinline__ int perm32(int rho) { const int n = rho >> 4, i = rho & 15; return 8 * (i >> 2) + 4 * n + (i & 3); }

struct Unit { int pm, pn, seg; };
struct Gemm { const bf16_t* A; const bf16_t* Bt; int M, N, K; const bf16_t* A2; const bf16_t* Bt2; };

struct StaticOrder {
    int nM, nN, nwg, G, c, reps = 1, segs = 1;
    __host__ __device__ void init(int M, int N, int G_, int c_) { nM = M / BM; nN = N / BM; nwg = nM * nN; G = G_; c = c_; }
    __host__ __device__ bool next(int i, Unit& u) const {
        const int ii = i / segs; u.seg = i - ii * segs;
        const long L = (long)ii * G + c; if (L >= (long)nwg * reps) return false;
        int wgid = (int)(L % nwg); { const int q = nwg / NXCD, r = nwg % NXCD, xcd = wgid % NXCD, off = wgid / NXCD; wgid = (xcd < r ? xcd * (q + 1) : r * (q + 1) + (xcd - r) * q) + off; }
        const int nig = WGM * nN, gid = wgid / nig, fm = gid * WGM, gsz = (nM - fm) < WGM ? (nM - fm) : WGM;
        u.pm = fm + ((wgid % nig) % gsz); u.pn = (wgid % nig) / gsz; return true;
    }
    __device__ __forceinline__ void a_ready(const Unit&) const {}
    __device__ __forceinline__ void done(const Unit&) const {}
};
__device__ __forceinline__ unsigned cvt_pk_bf16(float lo, float hi) { unsigned r; asm volatile("v_cvt_pk_bf16_f32 %0, %1, %2" : "=v"(r) : "v"(lo), "v"(hi)); return r; }
typedef float f32x2 __attribute__((ext_vector_type(2)));

template <class Epi, class Sched, bool STAMP = false>
__device__ __forceinline__ void gemm_phase(PG8_LAS unsigned char* lds, const Gemm g, const Sched& S, const Epi& E, unsigned long long* stamps) {
    const int tid = threadIdx.x, wid = __builtin_amdgcn_readfirstlane(tid >> 6), lane = tid & 63, wr = wid >> 2, wc = wid & 3, fr = lane & 15, fq = lane >> 4;
    const int K = g.K, nt = K / BK;
    int ts_lo = 0, ts_hi = 0, nts = 0; const unsigned long long rt_entry = STAMP ? (unsigned long long)wall_clock64() : 0ull;
#define PG8_STAMP() do { if (STAMP && wid == 0 && nts < 64) { const unsigned long long _c = (unsigned long long)clock64(); \
        ts_lo = (lane == nts) ? (int)(unsigned)_c : ts_lo; ts_hi = (lane == nts) ? (int)(unsigned)(_c >> 32) : ts_hi; ++nts; } } while (0)
    PG8_STAMP();
    unsigned voffA[2], voffB[2];
#pragma unroll
    for (int i = 0; i < 2; ++i) { int R, C; stage_rc(tid * 16 + i * 8192, R, C); const int Rb = Epi::PERM ? ((R & ~31) + perm32(R & 31)) : R;
        voffA[i] = (unsigned)(R * K + C) * 2u; voffB[i] = (unsigned)(Rb * K + C) * 2u; }
    const size_t kstep = (size_t)(BK * 2);
    const size_t hstep = (size_t)HALF * K * 2;
    const size_t tstep = 2 * hstep;
    const unsigned ldsw = (unsigned)wid * 1024u;
    const int aoff = lds_byte(wr * 64 + fr, fq * 8), boff = lds_byte(wc * 32 + fr, fq * 8);
#define PG8_SA(b, h) (((b) * 2 + (h)) * HTB)
#define PG8_SB(b, h) ((4 + (b) * 2 + (h)) * HTB)
#define PG8_STAGE(bufoff, gbase, voff) do { _Pragma("unroll") for (int _i = 0; _i < 2; ++_i) \
        __builtin_amdgcn_global_load_lds((const unsigned*)((const char*)(gbase) + (voff)[_i]), (PG8_LAS unsigned*)(lds + (bufoff) + ldsw + _i * 8192), 16, 0, 0); } while (0)
#define PG8_LDA(dst, b, h) do { _Pragma("unroll") for (int m = 0; m < 4; ++m) _Pragma("unroll") for (int k = 0; k < 2; ++k) dst[m][k] = *(const PG8_LAS bf16x8*)(lds + PG8_SA(b, h) + aoff + m * 2048 + k * 1024); } while (0)
#define PG8_LDB(dst, b, h) do { _Pragma("unroll") for (int n = 0; n < 2; ++n) _Pragma("unroll") for (int k = 0; k < 2; ++k) dst[n][k] = *(const PG8_LAS bf16x8*)(lds + PG8_SB(b, h) + boff + n * 2048 + k * 1024); } while (0)
#define PG8_MMA(ai, bj, At, Bt) do { __builtin_amdgcn_s_setprio(1); _Pragma("unroll") for (int m = 0; m < 4; ++m) _Pragma("unroll") for (int n = 0; n < 2; ++n) _Pragma("unroll") for (int k = 0; k < 2; ++k) \
        acc[ai][bj][m][n] = __builtin_amdgcn_mfma_f32_16x16x32_bf16(Bt[n][k], At[m][k], acc[ai][bj][m][n], 0, 0, 0); __builtin_amdgcn_s_setprio(0); } while (0)
#define PG8_WAIT_V(n) asm volatile("s_waitcnt vmcnt(" #n ")" ::: "memory")
#define PG8_WAIT_L(n) asm volatile("s_waitcnt lgkmcnt(" #n ")" ::: "memory")
#define PG8_BAR __builtin_amdgcn_s_barrier()
#define PG8_SCHED __builtin_amdgcn_sched_barrier(0)
    Unit cur, nxt; int ui = 0;
    if (!S.next(0, cur)) return;
    f32x4 acc[2][2][4][2];
#pragma unroll
    for (int a = 0; a < 2; ++a)
#pragma unroll
        for (int b = 0; b < 2; ++b)
#pragma unroll
            for (int m = 0; m < 4; ++m)
#pragma unroll
                for (int n = 0; n < 2; ++n) acc[a][b][m][n] = (f32x4){0.f, 0.f, 0.f, 0.f};
    bf16x8 At[4][2], B0[2][2], B1[2][2];
    const char* cA = (const char*)(cur.seg ? g.A2 : g.A) + (size_t)cur.pm * tstep; const char* cB = (const char*)(cur.seg ? g.Bt2 : g.Bt) + (size_t)cur.pn * tstep;
    S.a_ready(cur);
    PG8_STAGE(PG8_SB(0, 0), cB, voffB); PG8_STAGE(PG8_SA(0, 0), cA, voffA); PG8_STAGE(PG8_SB(0, 1), cB + hstep, voffB); PG8_STAGE(PG8_SA(0, 1), cA + hstep, voffA);
    if (wr == 1) PG8_BAR;
    PG8_WAIT_V(4); PG8_BAR;
    PG8_STAGE(PG8_SB(1, 0), cB + kstep, voffB); PG8_STAGE(PG8_SA(1, 0), cA + kstep, voffA); PG8_STAGE(PG8_SB(1, 1), cB + hstep + kstep, voffB);
    PG8_WAIT_V(6); PG8_BAR;
    PG8_STAMP();
    for (;;) {
        const bool has_next = S.next(ui + 1, nxt);
        const char* nA = has_next ? (const char*)(nxt.seg ? g.A2 : g.A) + (size_t)nxt.pm * tstep : cA; const char* nB = has_next ? (const char*)(nxt.seg ? g.Bt2 : g.Bt) + (size_t)nxt.pn * tstep : cB;
        for (int t = 0; t < nt; t += 2) {
            const bool last = (t == nt - 2);
            const char* a1 = cA + (size_t)(t + 1) * kstep;
            const char* a2 = last ? nA : cA + (size_t)(t + 2) * kstep; const char* b2 = last ? nB : cB + (size_t)(t + 2) * kstep;
            const char* a3 = a2 + kstep; const char* b3 = b2 + kstep;
            if (last && has_next) S.a_ready(nxt);
            PG8_LDB(B0, 0, 0); PG8_SCHED; PG8_LDA(At, 0, 0); PG8_STAGE(PG8_SA(1, 1), a1 + hstep, voffA);
            PG8_WAIT_L(8); PG8_BAR; PG8_WAIT_L(0); PG8_MMA(0, 0, At, B0); PG8_BAR; PG8_SCHED;
            PG8_LDB(B1, 0, 1); PG8_STAGE(PG8_SB(0, 0), b2, voffB);
            PG8_BAR; PG8_WAIT_L(0); PG8_MMA(0, 1, At, B1); PG8_BAR;
            PG8_LDA(At, 0, 1); PG8_STAGE(PG8_SA(0, 0), a2, voffA);
            PG8_BAR; PG8_WAIT_L(0); PG8_MMA(1, 0, At, B0); PG8_BAR; PG8_SCHED;
            PG8_STAGE(PG8_SB(0, 1), b2 + hstep, voffB);
            PG8_WAIT_V(6); PG8_BAR; PG8_MMA(1, 1, At, B1); PG8_BAR;
            PG8_LDB(B0, 1, 0); PG8_SCHED; PG8_LDA(At, 1, 0); PG8_STAGE(PG8_SA(0, 1), a2 + hstep, voffA);
            PG8_WAIT_L(8); PG8_BAR; PG8_WAIT_L(0); PG8_MMA(0, 0, At, B0); PG8_BAR; PG8_SCHED;
            PG8_LDB(B1, 1, 1); PG8_STAGE(PG8_SB(1, 0), b3, voffB);
            PG8_BAR; PG8_WAIT_L(0); PG8_MMA(0, 1, At, B1); PG8_BAR;
            PG8_LDA(At, 1, 1); PG8_STAGE(PG8_SA(1, 0), a3, voffA);
            PG8_BAR; PG8_WAIT_L(0); PG8_MMA(1, 0, At, B0); PG8_BAR; PG8_SCHED;
            PG8_STAGE(PG8_SB(1, 1), b3 + hstep, voffB);
            PG8_WAIT_V(6); PG8_BAR; PG8_MMA(1, 1, At, B1); PG8_BAR;
        }
        PG8_STAMP();
        bool keep_acc = false;
        if constexpr (Epi::TWOSEG) { if (cur.seg == 0) { E.mid(acc, cur, wr, wc, fr, fq); keep_acc = true; } else E(acc, cur, wr, wc, fr, fq); }
        else if constexpr (!Epi::AFTER_DRAIN) { E(acc, cur, wr, wc, fr, fq); S.done(cur); }
        PG8_STAMP();
        if (!has_next) break;
        if (!keep_acc)
#pragma unroll
        for (int a = 0; a < 2; ++a)
#pragma unroll
            for (int b = 0; b < 2; ++b)
#pragma unroll
                for (int m = 0; m < 4; ++m)
#pragma unroll
                    for (int n = 0; n < 2; ++n) acc[a][b][m][n] = (f32x4){0.f, 0.f, 0.f, 0.f};
        cur = nxt; cA = nA; cB = nB; ++ui;
    }
    PG8_WAIT_V(0);
    if (wr == 0) PG8_BAR;
    PG8_BAR;
    if constexpr (Epi::AFTER_DRAIN) { E.fused(acc, cur, wr, wc, fr, fq, lds, wid, lane); S.done(cur); }
    PG8_STAMP();
    if (STAMP && wid == 0) { stamps[lane] = lane < nts ? (((unsigned long long)(unsigned)ts_hi << 32) | (unsigned)ts_lo) : 0ull;
        if (lane == 62) stamps[62] = rt_entry; if (lane == 63) stamps[63] = (unsigned long long)wall_clock64(); }
#undef PG8_STAMP
#undef PG8_SA
#undef PG8_SB
#undef PG8_STAGE
#undef PG8_LDA
#undef PG8_LDB
#undef PG8_MMA
#undef PG8_WAIT_V
#undef PG8_WAIT_L
#undef PG8_BAR
#undef PG8_SCHED
}
}

namespace cg = cooperative_groups;
typedef unsigned short u16;
typedef pg8::f32x4 f32x4;
typedef pg8::bf16x8 bf16x8;
typedef pg8::u32x4 u32x4;
typedef unsigned u32x2 __attribute__((ext_vector_type(2)));
typedef unsigned long long u64;
#define LAS PG8_LAS
#define XB_TMO      128
#define XB_XCNT(j)  (256  + 64 * (j))
#define XB_XSUB(j)  (1280 + 64 * (j))
#define XB_XGEN(j)  (2304 + 64 * (j))
#define XB_TOP      3328
#define XB_TOPGEN   3392
#define XCD_BAR_WORDS 3456
#define XB_SPIN_CAP (1u << 18)

__device__ __forceinline__ unsigned xb_ld(unsigned* p)              { return __hip_atomic_load(p, __ATOMIC_RELAXED, __HIP_MEMORY_SCOPE_AGENT); }
__device__ __forceinline__ unsigned xb_add(unsigned* p, unsigned v) { return __hip_atomic_fetch_add(p, v, __ATOMIC_RELAXED, __HIP_MEMORY_SCOPE_AGENT); }
__device__ __forceinline__ unsigned xb_xcc_id() { return (unsigned)__builtin_amdgcn_s_getreg((3 << 11) | 20) & 0xFu; }
#define XB_SPIN(cond, bar) do { unsigned _sp = 0; while (cond) { __builtin_amdgcn_s_sleep(1); \
    if ((++_sp & 255u) == 0u) { if (xb_ld(&(bar)[XB_TMO])) break; if (_sp > XB_SPIN_CAP) { atomicAdd(&(bar)[XB_TMO], 1u); break; } } } } while (0)

struct XcdBarrier {
    unsigned* bar; unsigned x;
    volatile LAS unsigned* st;
};

__device__ __forceinline__ XcdBarrier xcd_barrier_post(unsigned* bar, volatile LAS unsigned* st) {
    XcdBarrier b; b.bar = bar; b.x = xb_xcc_id(); b.st = st;
    if (threadIdx.x == 0) (void)xb_add(&bar[XB_XCNT(b.x)], 1u);
    return b;
}
__device__ __forceinline__ void xcd_barrier_complete(unsigned* bar, unsigned x, unsigned& nloc, unsigned& nx) {
    const unsigned G = gridDim.x * gridDim.y * gridDim.z;
    unsigned sum, cnt, mine, sp = 0u;
    for (;;) {
        sum = 0u; cnt = 0u; mine = 0u;
#pragma unroll
        for (unsigned j = 0; j < 16; ++j) { const unsigned c = xb_ld(&bar[XB_XCNT(j)]); sum += c; cnt += (c > 0u) ? 1u : 0u; mine = (j == x) ? c : mine; }
        if (sum == G) break;
        __builtin_amdgcn_s_sleep(1);
        if ((++sp & 255u) == 0u) { if (xb_ld(&bar[XB_TMO])) break; if (sp > XB_SPIN_CAP) { atomicAdd(&bar[XB_TMO], 1u); break; } }
    }
    nloc = mine > 0u ? mine : 1u; nx = cnt > 0u ? cnt : 1u;
}

__device__ __forceinline__ void xcd_barrier(const XcdBarrier& b) {
    asm volatile("s_waitcnt vmcnt(0)" ::: "memory");
    __syncthreads();
    if (threadIdx.x == 0) {
        unsigned* bar = b.bar;
        __builtin_amdgcn_s_waitcnt(0);
        unsigned nloc = b.st[0], nx = b.st[1];
        if (nloc == 0u) { xcd_barrier_complete(bar, b.x, nloc, nx); b.st[0] = nloc; b.st[1] = nx; }
        const unsigned old = xb_add(&bar[XB_XSUB(b.x)], 1u);
        const unsigned gen = old / nloc;
        if (old + 1u == (gen + 1u) * nloc) {
            __builtin_amdgcn_fence(__ATOMIC_RELEASE, "agent");
            asm volatile("s_waitcnt vmcnt(0)" ::: "memory");
            const unsigned og = xb_add(&bar[XB_TOP], 1u);
            const unsigned tg = og / nx;
            if (og + 1u == (tg + 1u) * nx) xb_add(&bar[XB_TOPGEN], 1u);
            else XB_SPIN(xb_ld(&bar[XB_TOPGEN]) == tg, bar);
            __builtin_amdgcn_fence(__ATOMIC_ACQUIRE, "agent");
            xb_add(&bar[XB_XGEN(b.x)], 1u);
            asm volatile("s_waitcnt vmcnt(0)" ::: "memory");
        } else {
            XB_SPIN(xb_ld(&bar[XB_XGEN(b.x)]) == gen, bar);
            __builtin_amdgcn_fence(__ATOMIC_ACQUIRE, "agent");
            asm volatile("s_waitcnt vmcnt(0)" ::: "memory");
        }
    }
    __syncthreads();
}

constexpr int NB = 8, T = 4096, D = 1024, M = NB * T;
constexpr int DIN = 6216, NIN = 6400, DFF = 4096;
constexpr float EPSV = 1e-6f;
constexpr size_t MiB = (size_t)1 << 20;
constexpr size_t WS_WT_IN = 0, WS_WT_ORNN = 13 * MiB, WS_WT_OATT = 15 * MiB, WS_WT_OUT = 17 * MiB, WS_WT_FFIN = 19 * MiB, WS_WT_FFOUT = 27 * MiB;
constexpr size_t WS_WT_GATE = 35 * MiB;
constexpr size_t WS_ROWSS = 35 * MiB + 512 * 1024;
constexpr size_t WS_SPL = 35 * MiB + 768 * 1024;
constexpr size_t WS_PEND = 36 * MiB, WS_HEND = 38 * MiB;
constexpr size_t WS_IKW = 40 * MiB;
constexpr size_t WS_IKN = 49 * MiB;
constexpr size_t WS_KB = 53 * MiB, WS_VB = 69 * MiB, WS_VT = 85 * MiB;
constexpr size_t WS_MASK = 101 * MiB;
constexpr size_t WS_IQ = 117 * MiB;
constexpr size_t WS_SLAB = 149 * MiB;
constexpr size_t WS_HB = 213 * MiB;
constexpr size_t WS_RX = 277 * MiB;
constexpr size_t WS_GT = 341 * MiB;
constexpr size_t WS_QB = 405 * MiB;
constexpr size_t WS_XW = 40 * MiB;
constexpr size_t WS_HID = 117 * MiB;
constexpr size_t WS_END = 469 * MiB;
constexpr int LDS_BYTES = 131072 + 64;
constexpr size_t WS_BAR = 35 * MiB + 832 * 1024;
#ifndef PROBE_DBL
#define PROBE_DBL 0
#endif

struct Params {
    const float* in[20];
    float* out;
    unsigned char* ws;
    int ph_lo, ph_hi, dbl, pad_;
};
enum { I_X = 0, I_N1W, I_WIN, I_CONVW, I_CONVB, I_WA, I_BA, I_WX, I_BX, I_LAM, I_QNW, I_KNW, I_IKNW, I_WORNN, I_WOATT, I_GATEB, I_WOUT, I_N2W, I_WFFIN, I_WFFOUT };

__device__ __forceinline__ unsigned pk2(float a, float b) { return pg8::cvt_pk_bf16(a, b); }
__device__ __forceinline__ u16 f2bf(float f) { return (u16)(pk2(f, 0.f) & 0xffffu); }
__device__ __forceinline__ float bflo(unsigned w) { return __uint_as_float(w << 16); }
__device__ __forceinline__ float bfhi(unsigned w) { return __uint_as_float(w & 0xffff0000u); }
__device__ __forceinline__ float bf2f(u16 v) { return __uint_as_float(((unsigned)v) << 16); }
__device__ __forceinline__ float wave_sum(float v) {
#pragma unroll
    for (int o = 32; o; o >>= 1) v += __shfl_xor(v, o);
    return v;
}
__device__ __forceinline__ float sigmoidf_(float v) { return __builtin_amdgcn_rcpf(1.0f + __expf(-v)); }
__device__ __forceinline__ float gelu_tanh(float x) { const float z = 0.7978845608f * (x + 0.044715f * x * x * x); return x * __builtin_amdgcn_rcpf(1.0f + __expf(-2.0f * z)); }
__device__ __forceinline__ bf16x8 as_bf16x8(u32x4 w) { union { u32x4 a; bf16x8 b; } c; c.a = w; return c.b; }

template <class MapF>
__device__ __forceinline__ void transpose_w(const float* __restrict__ src, int ld, u16* __restrict__ dst, int K, int Nd, MapF map, int gw, int GW, int lane) {
    const int nblk = Nd >> 6, items = nblk * (K >> 3);
    for (int it = gw; it < items; it += GW) {
        const int nb = it % nblk, kb = it / nblk, n = nb * 64 + lane, k0 = kb * 8, col = map(n);
        float v[8];
#pragma unroll
        for (int j = 0; j < 8; ++j) v[j] = col >= 0 ? src[(size_t)(k0 + j) * ld + col] : 0.f;
        u32x4 w; w.x = pk2(v[0], v[1]); w.y = pk2(v[2], v[3]); w.z = pk2(v[4], v[5]); w.w = pk2(v[6], v[7]);
        *(u32x4*)(dst + (size_t)n * K + k0) = w;
    }
}
struct MapIn { __device__ int operator()(int n) const { return n < 4096 ? n : (n < 6144 ? n + 72 : (n < 6216 ? n - 2048 : -1)); } };
struct MapId { __device__ int operator()(int n) const { return n; } };

__device__ void prepass(const Params& p) {
    const int tid = threadIdx.x, lane = tid & 63, gw = blockIdx.x * 8 + (tid >> 6), GW = gridDim.x * 8;
    unsigned char* ws = p.ws;
    {
        const float* x = p.in[I_X]; const float* nw = p.in[I_N1W]; u16* hb = (u16*)(ws + WS_HB);
        const f32x4 w0 = *(const f32x4*)(nw + 8 * lane), w1 = *(const f32x4*)(nw + 8 * lane + 4), w2 = *(const f32x4*)(nw + 512 + 8 * lane), w3 = *(const f32x4*)(nw + 512 + 8 * lane + 4);
        for (int row0 = gw; row0 < M; row0 += 2 * GW) {
            f32x4 a[2][4];
#pragma unroll
            for (int z = 0; z < 2; ++z) {
                const float* xr = x + (size_t)(row0 + z * GW) * D + 8 * lane;
                a[z][0] = *(const f32x4*)xr; a[z][1] = *(const f32x4*)(xr + 4); a[z][2] = *(const f32x4*)(xr + 512); a[z][3] = *(const f32x4*)(xr + 516);
            }
#pragma unroll
            for (int z = 0; z < 2; ++z) {
                float ss = 0.f;
#pragma unroll
                for (int j = 0; j < 4; ++j) ss += a[z][0][j] * a[z][0][j] + a[z][1][j] * a[z][1][j] + a[z][2][j] * a[z][2][j] + a[z][3][j] * a[z][3][j];
                ss = wave_sum(ss);
                const float rs = rsqrtf(ss * (1.0f / 1024.0f) + EPSV);
                const f32x4 a0 = a[z][0] * rs * w0, a1 = a[z][1] * rs * w1, a2 = a[z][2] * rs * w2, a3 = a[z][3] * rs * w3;
                u32x4 o0, o1; o0.x = pk2(a0[0], a0[1]); o0.y = pk2(a0[2], a0[3]); o0.z = pk2(a1[0], a1[1]); o0.w = pk2(a1[2], a1[3]);
                o1.x = pk2(a2[0], a2[1]); o1.y = pk2(a2[2], a2[3]); o1.z = pk2(a3[0], a3[1]); o1.w = pk2(a3[2], a3[3]);
                u16* hr = hb + (size_t)(row0 + z * GW) * D + 8 * lane;
                *(u32x4*)hr = o0; *(u32x4*)(hr + 512) = o1;
            }
        }
    }
    transpose_w(p.in[I_WIN], DIN, (u16*)(ws + WS_WT_IN), 1024, NIN, MapIn(), gw, GW, lane);
    transpose_w(p.in[I_WORNN], 1024, (u16*)(ws + WS_WT_ORNN), 1024, 1024, MapId(), gw, GW, lane);
    transpose_w(p.in[I_WOATT], 1024, (u16*)(ws + WS_WT_OATT), 1024, 1024, MapId(), gw, GW, lane);
    transpose_w(p.in[I_WOUT], 1024, (u16*)(ws + WS_WT_OUT), 1024, 1024, MapId(), gw, GW, lane);
    transpose_w(p.in[I_WFFIN], DFF, (u16*)(ws + WS_WT_FFIN), 1024, DFF, MapId(), gw, GW, lane);
    transpose_w(p.in[I_WFFOUT], 1024, (u16*)(ws + WS_WT_FFOUT), DFF, 1024, MapId(), gw, GW, lane);
    {
        u16* wt = (u16*)(ws + WS_WT_GATE);
        const int gt = blockIdx.x * 512 + tid, GT = gridDim.x * 512;
        for (int i = gt; i < 2 * 65536; i += GT) {
            const int which = i >> 16, r = i & 65535, n = r >> 12, e = (r >> 6) & 63, d = r & 63;
            const float* src = which ? p.in[I_WX] : p.in[I_WA];
            wt[i] = f2bf(src[n * 4096 + d * 64 + e]);
        }
        float* rowss = (float*)(ws + WS_ROWSS);
        for (int i = gt; i < M; i += GT) rowss[i] = 0.f;
        float* spl = (float*)(ws + WS_SPL);
        for (int i = gt; i < 1024; i += GT) spl[i] = -8.0f * log1pf(expf(-p.in[I_LAM][i]));
    }
}

struct EpiG1 {
    static constexpr bool PERM = true, AFTER_DRAIN = false, TWOSEG = false;
    u16 *rx, *gt, *qb, *kb, *vb, *iq, *gb; float* ikw; const float* gate_b;
    __device__ __forceinline__ void operator()(const f32x4 (&acc)[2][2][4][2], const pg8::Unit& u, int wr, int wc, int fr, int fq) const {
        const int row0 = u.pm * 256 + wr * 64 + fr, pn = u.pn, cl = wc * 32 + 8 * fq;
        int mode = 0, ld = 1024; u16* base = rx;
        if (pn < 4) { base = rx + pn * 256; }
        else if (pn < 8) { mode = 1; base = gt + (pn - 4) * 256; }
        else if (pn < 12) { base = qb + (pn - 8) * 256; }
        else if (pn == 12) { base = kb; ld = 256; }
        else if (pn == 13) { base = vb; ld = 256; }
        else if (pn < 16) { base = iq + (pn - 14) * 256; ld = 512; }
        else if (pn < 24) { mode = 2; base = gb + (pn - 16) * 256; ld = 2048; }
        else mode = 3;
        const float* bsrc = gate_b + ((mode == 2) ? (pn - 16) * 256 : 0) + cl;
#pragma unroll
        for (int ai = 0; ai < 2; ++ai)
#pragma unroll
            for (int m = 0; m < 4; ++m) {
                const size_t row = (size_t)(row0 + ai * 128 + m * 16);
                if (mode == 3) {
                    if (cl <= 64) { float* rp = ikw + row * 72 + cl; *(f32x4*)rp = acc[ai][0][m][0]; *(f32x4*)(rp + 4) = acc[ai][0][m][1]; }
                } else {
                    u16* rowp = base + row * ld + cl;
#pragma unroll
                    for (int bj = 0; bj < 2; ++bj) {
                        f32x4 v0 = acc[ai][bj][m][0], v1 = acc[ai][bj][m][1];
                        if (mode == 1) {
#pragma unroll
                            for (int j = 0; j < 4; ++j) { v0[j] = gelu_tanh(v0[j]); v1[j] = gelu_tanh(v1[j]); }
                        } else if (mode == 2) {
                            const f32x4 b0 = *(const f32x4*)(bsrc + bj * 128), b1 = *(const f32x4*)(bsrc + bj * 128 + 4);
#pragma unroll
                            for (int j = 0; j < 4; ++j) { v0[j] = sigmoidf_(v0[j] + b0[j]); v1[j] = sigmoidf_(v1[j] + b1[j]); }
                        }
                        u32x4 w; w.x = pk2(v0[0], v0[1]); w.y = pk2(v0[2], v0[3]); w.z = pk2(v1[0], v1[1]); w.w = pk2(v1[2], v1[3]);
                        *(u32x4*)(rowp + bj * 128) = w;
                    }
                }
            }
    }
};
struct EpiGate {
    static constexpr bool PERM = true, AFTER_DRAIN = false, TWOSEG = false;
    u16* O; const u16* gsrc; const u16* addsrc;
    __device__ __forceinline__ void operator()(const f32x4 (&acc)[2][2][4][2], const pg8::Unit& u, int wr, int wc, int fr, int fq) const {
        const int row0 = u.pm * 256 + wr * 64 + fr, col0 = u.pn * 256 + wc * 32 + 8 * fq;
#pragma unroll
        for (int ai = 0; ai < 2; ++ai)
#pragma unroll
            for (int m = 0; m < 4; ++m) {
                const size_t row = (size_t)(row0 + ai * 128 + m * 16);
#pragma unroll
                for (int bj = 0; bj < 2; ++bj) {
                    const int col = col0 + bj * 128;
                    const u32x4 gw = *(const u32x4*)(gsrc + row * 2048 + col);
                    u32x4 aw = {0u, 0u, 0u, 0u};
                    if (addsrc) aw = *(const u32x4*)(addsrc + row * 1024 + col);
                    const f32x4 v0 = acc[ai][bj][m][0], v1 = acc[ai][bj][m][1];
                    u32x4 w;
                    w.x = pk2(bflo(aw.x) + bflo(gw.x) * v0[0], bfhi(aw.x) + bfhi(gw.x) * v0[1]);
                    w.y = pk2(bflo(aw.y) + bflo(gw.y) * v0[2], bfhi(aw.y) + bfhi(gw.y) * v0[3]);
                    w.z = pk2(bflo(aw.z) + bflo(gw.z) * v1[0], bfhi(aw.z) + bfhi(gw.z) * v1[1]);
                    w.w = pk2(bflo(aw.w) + bflo(gw.w) * v1[2], bfhi(aw.w) + bfhi(gw.w) * v1[3]);
                    *(u32x4*)(O + row * 1024 + col) = w;
                }
            }
    }
};
struct EpiGate2 {
    static constexpr bool PERM = true, AFTER_DRAIN = false, TWOSEG = true;
    u16* O; const u16* gb;
    __device__ __forceinline__ void mid(f32x4 (&acc)[2][2][4][2], const pg8::Unit& u, int wr, int wc, int fr, int fq) const {
        const int row0 = u.pm * 256 + wr * 64 + fr, col0 = u.pn * 256 + wc * 32 + 8 * fq;
#pragma unroll
        for (int ai = 0; ai < 2; ++ai)
#pragma unroll
            for (int m = 0; m < 4; ++m) {
                const size_t row = (size_t)(row0 + ai * 128 + m * 16);
#pragma unroll
                for (int bj = 0; bj < 2; ++bj) {
                    const int col = col0 + bj * 128;
                    const u32x4 g0 = *(const u32x4*)(gb + row * 2048 + col), g1 = *(const u32x4*)(gb + row * 2048 + 1024 + col);
                    f32x4& v0 = acc[ai][bj][m][0]; f32x4& v1 = acc[ai][bj][m][1];
                    v0[0] *= bflo(g0.x) * __builtin_amdgcn_rcpf(bflo(g1.x)); v0[1] *= bfhi(g0.x) * __builtin_amdgcn_rcpf(bfhi(g1.x)); v0[2] *= bflo(g0.y) * __builtin_amdgcn_rcpf(bflo(g1.y)); v0[3] *= bfhi(g0.y) * __builtin_amdgcn_rcpf(bfhi(g1.y));
                    v1[0] *= bflo(g0.z) * __builtin_amdgcn_rcpf(bflo(g1.z)); v1[1] *= bfhi(g0.z) * __builtin_amdgcn_rcpf(bfhi(g1.z)); v1[2] *= bflo(g0.w) * __builtin_amdgcn_rcpf(bflo(g1.w)); v1[3] *= bfhi(g0.w) * __builtin_amdgcn_rcpf(bfhi(g1.w));
                }
            }
    }
    __device__ __forceinline__ void operator()(const f32x4 (&acc)[2][2][4][2], const pg8::Unit& u, int wr, int wc, int fr, int fq) const {
        const int row0 = u.pm * 256 + wr * 64 + fr, col0 = u.pn * 256 + wc * 32 + 8 * fq;
#pragma unroll
        for (int ai = 0; ai < 2; ++ai)
#pragma unroll
            for (int m = 0; m < 4; ++m) {
                const size_t row = (size_t)(row0 + ai * 128 + m * 16);
#pragma unroll
                for (int bj = 0; bj < 2; ++bj) {
                    const int col = col0 + bj * 128;
                    const u32x4 g1 = *(const u32x4*)(gb + row * 2048 + 1024 + col);
                    const f32x4 v0 = acc[ai][bj][m][0], v1 = acc[ai][bj][m][1];
                    u32x4 w;
                    w.x = pk2(bflo(g1.x) * v0[0], bfhi(g1.x) * v0[1]); w.y = pk2(bflo(g1.y) * v0[2], bfhi(g1.y) * v0[3]);
                    w.z = pk2(bflo(g1.z) * v1[0], bfhi(g1.z) * v1[1]); w.w = pk2(bflo(g1.w) * v1[2], bfhi(g1.w) * v1[3]);
                    *(u32x4*)(O + row * 1024 + col) = w;
                }
            }
    }
};
struct EpiRes1 {
    static constexpr bool PERM = true, AFTER_DRAIN = false, TWOSEG = false;
    const float* x; float* out; u16* xw; const float* n2w; float* rowss;
    __device__ __forceinline__ void operator()(const f32x4 (&acc)[2][2][4][2], const pg8::Unit& u, int wr, int wc, int fr, int fq) const {
        const int row0 = u.pm * 256 + wr * 64 + fr, col0 = u.pn * 256 + wc * 32 + 8 * fq;
        f32x4 nw[2][2];
#pragma unroll
        for (int bj = 0; bj < 2; ++bj)
#pragma unroll
            for (int n = 0; n < 2; ++n) nw[bj][n] = *(const f32x4*)(n2w + col0 + bj * 128 + 4 * n);
#pragma unroll
        for (int ai = 0; ai < 2; ++ai)
#pragma unroll
            for (int m = 0; m < 4; ++m) {
                const size_t row = (size_t)(row0 + ai * 128 + m * 16);
                float ss = 0.f;
#pragma unroll
                for (int bj = 0; bj < 2; ++bj) {
                    const int col = col0 + bj * 128;
                    const float* xp = x + row * 1024 + col;
                    f32x4 v0 = *(const f32x4*)xp + acc[ai][bj][m][0], v1 = *(const f32x4*)(xp + 4) + acc[ai][bj][m][1];
                    float* op = out + row * 1024 + col;
                    *(f32x4*)op = v0; *(f32x4*)(op + 4) = v1;
#pragma unroll
                    for (int j = 0; j < 4; ++j) ss += v0[j] * v0[j] + v1[j] * v1[j];
                    v0 = v0 * nw[bj][0]; v1 = v1 * nw[bj][1];
                    u32x4 w; w.x = pk2(v0[0], v0[1]); w.y = pk2(v0[2], v0[3]); w.z = pk2(v1[0], v1[1]); w.w = pk2(v1[2], v1[3]);
                    *(u32x4*)(xw + row * 1024 + col) = w;
                }
                ss += __shfl_xor(ss, 16); ss += __shfl_xor(ss, 32);
                if (fq == 0) atomicAdd(rowss + row, ss);
            }
    }
};
struct EpiFF1 {
    static constexpr bool PERM = true, AFTER_DRAIN = false, TWOSEG = false;
    u16* hid; const float* rowss;
    __device__ __forceinline__ void operator()(const f32x4 (&acc)[2][2][4][2], const pg8::Unit& u, int wr, int wc, int fr, int fq) const {
        const int row0 = u.pm * 256 + wr * 64 + fr, col0 = u.pn * 256 + wc * 32 + 8 * fq;
#pragma unroll
        for (int ai = 0; ai < 2; ++ai)
#pragma unroll
            for (int m = 0; m < 4; ++m) {
                const size_t row = (size_t)(row0 + ai * 128 + m * 16);
                const float rs = rsqrtf(rowss[row] * (1.0f / 1024.0f) + EPSV);
#pragma unroll
                for (int bj = 0; bj < 2; ++bj) {
                    f32x4 v0 = acc[ai][bj][m][0] * rs, v1 = acc[ai][bj][m][1] * rs;
#pragma unroll
                    for (int j = 0; j < 4; ++j) { const float a = fmaxf(v0[j], 0.f), b = fmaxf(v1[j], 0.f); v0[j] = a * a; v1[j] = b * b; }
                    u32x4 w; w.x = pk2(v0[0], v0[1]); w.y = pk2(v0[2], v0[3]); w.z = pk2(v1[0], v1[1]); w.w = pk2(v1[2], v1[3]);
                    *(u32x4*)(hid + row * DFF + col0 + bj * 128) = w;
                }
            }
    }
};
struct EpiRes2 {
    static constexpr bool PERM = true, AFTER_DRAIN = false, TWOSEG = false;
    float* out;
    __device__ __forceinline__ void operator()(const f32x4 (&acc)[2][2][4][2], const pg8::Unit& u, int wr, int wc, int fr, int fq) const {
        const int row0 = u.pm * 256 + wr * 64 + fr, col0 = u.pn * 256 + wc * 32 + 8 * fq;
#pragma unroll
        for (int ai = 0; ai < 2; ++ai)
#pragma unroll
            for (int m = 0; m < 4; ++m) {
                const size_t row = (size_t)(row0 + ai * 128 + m * 16);
#pragma unroll
                for (int bj = 0; bj < 2; ++bj) {
                    float* op = out + row * 1024 + col0 + bj * 128;
                    *(f32x4*)op = *(const f32x4*)op + acc[ai][bj][m][0];
                    *(f32x4*)(op + 4) = *(const f32x4*)(op + 4) + acc[ai][bj][m][1];
                }
            }
    }
};
template <class Epi>
__device__ __forceinline__ void run_gemm(LAS unsigned char* L, const u16* A, const u16* Bt, int N, int K, const Epi& E, int reps = 1) {
    pg8::Gemm g; g.A = A; g.Bt = Bt; g.M = M; g.N = N; g.K = K; g.A2 = A; g.Bt2 = Bt;
    pg8::StaticOrder S; S.init(M, N, (int)gridDim.x, (int)blockIdx.x); S.reps = reps;
    pg8::gemm_phase<Epi, pg8::StaticOrder, false>(L, g, S, E, nullptr);
}

template <class Epi>
__device__ __forceinline__ void run_gemm2(LAS unsigned char* L, const u16* A, const u16* Bt, const u16* A2, const u16* Bt2, int N, int K, const Epi& E) {
    pg8::Gemm g; g.A = A; g.Bt = Bt; g.M = M; g.N = N; g.K = K; g.A2 = A2; g.Bt2 = Bt2;
    pg8::StaticOrder S; S.init(M, N, (int)gridDim.x, (int)blockIdx.x); S.segs = 2;
    pg8::gemm_phase<Epi, pg8::StaticOrder, false>(L, g, S, E, nullptr);
}

__device__ void norm_phase(const Params& p) {
    const int tid = threadIdx.x, lane = tid & 63, gw = blockIdx.x * 8 + (tid >> 6), GW = gridDim.x * 8;
    unsigned char* ws = p.ws;
    u16* qb = (u16*)(ws + WS_QB); u16* kb = (u16*)(ws + WS_KB); const u16* vb = (const u16*)(ws + WS_VB); u16* vT = (u16*)(ws + WS_VT);
    const float* ikw = (const float*)(ws + WS_IKW); u16* ikn = (u16*)(ws + WS_IKN);
    const float* qnw = p.in[I_QNW] + (lane & 3) * 16; const float* knw = p.in[I_KNW] + (lane & 15) * 4; const float iknw = p.in[I_IKNW][lane];
    f32x4 qw4[4]; for (int i = 0; i < 4; ++i) qw4[i] = *(const f32x4*)(qnw + 4 * i);
    const f32x4 kw4 = *(const f32x4*)knw;
    for (int row0 = gw; row0 < M; row0 += 2 * GW) {
        u32x4 qw0[2], qw1[2]; u32x2 kw[2]; float iv[2];
#pragma unroll
        for (int z = 0; z < 2; ++z) {
            const size_t row = (size_t)(row0 + z * GW);
            const u16* qr = qb + row * 1024 + 16 * lane;
            qw0[z] = *(const u32x4*)qr; qw1[z] = *(const u32x4*)(qr + 8);
            kw[z] = *(const u32x2*)(kb + row * 256 + 4 * lane);
            iv[z] = ikw[row * 72 + lane];
        }
#pragma unroll
        for (int z = 0; z < 2; ++z) {
            const size_t row = (size_t)(row0 + z * GW);
            {
                u32x4 w0 = qw0[z], w1 = qw1[z];
                float v[16];
                v[0] = bflo(w0.x); v[1] = bfhi(w0.x); v[2] = bflo(w0.y); v[3] = bfhi(w0.y); v[4] = bflo(w0.z); v[5] = bfhi(w0.z); v[6] = bflo(w0.w); v[7] = bfhi(w0.w);
                v[8] = bflo(w1.x); v[9] = bfhi(w1.x); v[10] = bflo(w1.y); v[11] = bfhi(w1.y); v[12] = bflo(w1.z); v[13] = bfhi(w1.z); v[14] = bflo(w1.w); v[15] = bfhi(w1.w);
                float ss = 0.f;
#pragma unroll
                for (int j = 0; j < 16; ++j) ss += v[j] * v[j];
                ss += __shfl_xor(ss, 1); ss += __shfl_xor(ss, 2);
                const float rs = rsqrtf(ss * (1.0f / 64.0f) + EPSV) * 0.18033688011f;
#pragma unroll
                for (int j = 0; j < 16; ++j) v[j] = v[j] * rs * qw4[j >> 2][j & 3];
                w0.x = pk2(v[0], v[1]); w0.y = pk2(v[2], v[3]); w0.z = pk2(v[4], v[5]); w0.w = pk2(v[6], v[7]);
                w1.x = pk2(v[8], v[9]); w1.y = pk2(v[10], v[11]); w1.z = pk2(v[12], v[13]); w1.w = pk2(v[14], v[15]);
                u16* qr = qb + row * 1024 + 16 * lane;
                *(u32x4*)qr = w0; *(u32x4*)(qr + 8) = w1;
            }
            {
                u32x2 w = kw[z];
                const float v0 = bflo(w.x), v1 = bfhi(w.x), v2 = bflo(w.y), v3 = bfhi(w.y);
                float ss = v0 * v0 + v1 * v1 + v2 * v2 + v3 * v3;
                ss += __shfl_xor(ss, 1); ss += __shfl_xor(ss, 2); ss += __shfl_xor(ss, 4); ss += __shfl_xor(ss, 8);
                const float rs = rsqrtf(ss * (1.0f / 64.0f) + EPSV);
                w.x = pk2(v0 * rs * kw4[0], v1 * rs * kw4[1]); w.y = pk2(v2 * rs * kw4[2], v3 * rs * kw4[3]);
                *(u32x2*)(kb + row * 256 + 4 * lane) = w;
            }
            {
                const float ss = wave_sum(iv[z] * iv[z]);
                ikn[row * 64 + lane] = f2bf(iv[z] * rsqrtf(ss * (1.0f / 64.0f) + EPSV) * iknw);
            }
        }
    }
    for (int it = gw; it < NB * 4 * (T / 8); it += GW) {
        const int tg = it & 511, g = (it >> 9) & 3, b = it >> 11, t0 = tg * 8;
        const u16* src = vb + (size_t)(b * T + t0) * 256 + g * 64 + lane;
        u16 v[8];
#pragma unroll
        for (int j = 0; j < 8; ++j) v[j] = src[j * 256];
        u32x4 w; w.x = v[0] | ((unsigned)v[1] << 16); w.y = v[2] | ((unsigned)v[3] << 16); w.z = v[4] | ((unsigned)v[5] << 16); w.w = v[6] | ((unsigned)v[7] << 16);
        *(u32x4*)(vT + ((size_t)((b * 4 + g) * 64 + lane)) * T + t0) = w;
    }
}

template <int MODE>
__device__ void rnn_phase(const Params& p, LAS unsigned char* L, int reps) {
    const int tid = threadIdx.x, hb = tid >> 8, t2 = tid & 255, lane = tid & 63, wv = t2 >> 6, fr = lane & 15, fq = lane >> 4;
    const int ch = t2 & 63, qt = t2 >> 6;
    LAS unsigned char* Lh = L + hb * 55296;
    LAS float* xs = (LAS float*)Lh;
    LAS float* as = (LAS float*)Lh;
    LAS float* xcs = (LAS float*)(Lh + 17408);
    LAS float* us = (LAS float*)(Lh + 34816);
    LAS float* part = (LAS float*)(Lh + 52224);
    LAS float* cin = (LAS float*)(Lh + 54272);
    unsigned char* ws = p.ws;
    const u16* rx = (const u16*)(ws + WS_RX); u16* gt = (u16*)(ws + WS_GT);
    float* PEND = (float*)(ws + WS_PEND); float* HEND = (float*)(ws + WS_HEND);
    const u16* wgT = (const u16*)(ws + WS_WT_GATE); const float* spl = (const float*)(ws + WS_SPL);
    for (int it = blockIdx.x; it < 256 * reps; it += gridDim.x) {
        const int item = (it & 255) * 2 + hb, b = item >> 6, n = (item >> 2) & 15, seg = item & 3, gch = n * 64 + ch;
        const float cw0 = p.in[I_CONVW][gch], cw1 = p.in[I_CONVW][1024 + gch], cw2 = p.in[I_CONVW][2048 + gch], cw3 = p.in[I_CONVW][3072 + gch], cb = p.in[I_CONVB][gch];
        bf16x8 waf[4][2], wxf[4][2];
#pragma unroll
        for (int m = 0; m < 4; ++m)
#pragma unroll
            for (int ks = 0; ks < 2; ++ks) {
                const size_t o = (size_t)((n * 64 + 16 * m + fr) * 64 + 32 * ks + 8 * fq);
                waf[m][ks] = *(const bf16x8*)(wgT + o); wxf[m][ks] = *(const bf16x8*)(wgT + 65536 + o);
            }
        if (MODE == 1 && qt == 0) {
            float h = 0.f;
            for (int c0 = 0; c0 < seg * 16; c0 += 16) {
                float pe[16], he[16];
#pragma unroll
                for (int j = 0; j < 16; ++j) { const size_t o = (size_t)((b * 64 + c0 + j) * 1024 + gch); pe[j] = PEND[o]; he[j] = HEND[o]; }
#pragma unroll
                for (int j = 0; j < 16; ++j) h = pe[j] * h + he[j];
            }
            cin[ch] = h;
        }
        u32x4 xpre[3];
#pragma unroll
        for (int i = 0; i < 3; ++i) {
            const int rr = (t2 >> 3) + 32 * i, cg8 = t2 & 7, tt = seg * 1024 - 3 + rr;
            xpre[i] = (u32x4){0u, 0u, 0u, 0u};
            if (rr < 67 && tt >= 0) xpre[i] = *(const u32x4*)(rx + (size_t)(b * T + tt) * 1024 + n * 64 + cg8 * 8);
        }
        for (int cc = 0; cc < 16; ++cc) {
            const int c = seg * 16 + cc, t0 = c * 64;
#pragma unroll
            for (int i = 0; i < 3; ++i) {
                const int rr = (t2 >> 3) + 32 * i, cg8 = t2 & 7;
                if (rr < 67) {
                    const u32x4 w = xpre[i];
                    f32x4 lo = {bflo(w.x), bfhi(w.x), bflo(w.y), bfhi(w.y)}, hi = {bflo(w.z), bfhi(w.z), bflo(w.w), bfhi(w.w)};
                    *(LAS f32x4*)(xs + rr * 64 + cg8 * 8) = lo; *(LAS f32x4*)(xs + rr * 64 + cg8 * 8 + 4) = hi;
                }
            }
            if (cc < 15) {
#pragma unroll
                for (int i = 0; i < 3; ++i) {
                    const int rr = (t2 >> 3) + 32 * i, cg8 = t2 & 7, tt = t0 + 64 - 3 + rr;
                    if (rr < 67) xpre[i] = *(const u32x4*)(rx + (size_t)(b * T + tt) * 1024 + n * 64 + cg8 * 8);
                }
            }
            __syncthreads();
            {
                float x0 = xs[(16 * qt) * 64 + ch], x1 = xs[(16 * qt + 1) * 64 + ch], x2 = xs[(16 * qt + 2) * 64 + ch];
#pragma unroll
                for (int j = 0; j < 16; ++j) {
                    const int tt = 16 * qt + j;
                    const float x3 = xs[(tt + 3) * 64 + ch];
                    xcs[tt * 68 + ch] = cb + cw0 * x0 + cw1 * x1 + cw2 * x2 + cw3 * x3;
                    x0 = x1; x1 = x2; x2 = x3;
                }
            }
            __syncthreads();
            {
                const int trow = 16 * wv + fr;
                bf16x8 yf[2];
#pragma unroll
                for (int ks = 0; ks < 2; ++ks) {
                    const f32x4 a = *(const LAS f32x4*)(xcs + trow * 68 + 32 * ks + 8 * fq), bq = *(const LAS f32x4*)(xcs + trow * 68 + 32 * ks + 8 * fq + 4);
                    u32x4 w; w.x = pk2(a[0], a[1]); w.y = pk2(a[2], a[3]); w.z = pk2(bq[0], bq[1]); w.w = pk2(bq[2], bq[3]);
                    yf[ks] = as_bf16x8(w);
                }
#pragma unroll
                for (int m = 0; m < 4; ++m) {
                    f32x4 ga = {0.f, 0.f, 0.f, 0.f}, gx = {0.f, 0.f, 0.f, 0.f};
#pragma unroll
                    for (int ks = 0; ks < 2; ++ks) { ga = __builtin_amdgcn_mfma_f32_16x16x32_bf16(waf[m][ks], yf[ks], ga, 0, 0, 0); gx = __builtin_amdgcn_mfma_f32_16x16x32_bf16(wxf[m][ks], yf[ks], gx, 0, 0, 0); }
                    const int e0 = 16 * m + 4 * fq;
                    const f32x4 ba4 = *(const f32x4*)(p.in[I_BA] + n * 64 + e0), bx4 = *(const f32x4*)(p.in[I_BX] + n * 64 + e0), sp4 = *(const f32x4*)(spl + n * 64 + e0);
                    const f32x4 xc4 = *(const LAS f32x4*)(xcs + trow * 68 + e0);
                    f32x4 a4, u4;
#pragma unroll
                    for (int r = 0; r < 4; ++r) {
                        const float ra = sigmoidf_(ga[r] + ba4[r]), ri = sigmoidf_(gx[r] + bx4[r]);
                        const float la = ra * sp4[r];
                        const float a = __expf(la), z = 2.0f * la;
                        const float om = (z > -0.03f) ? -z * (1.0f + z * (0.5f + z * (0.16666667f + z * 0.041666667f))) : 1.0f - a * a;
                        a4[r] = a;
                        u4[r] = __builtin_amdgcn_sqrtf(om) * (ri * xc4[r]);
                    }
                    *(LAS f32x4*)(as + trow * 68 + e0) = a4; *(LAS f32x4*)(us + trow * 68 + e0) = u4;
                }
            }
            __syncthreads();
            u16 gpre[16];
            if (MODE == 1) {
                const u16* gp = gt + (size_t)(b * T + t0 + 16 * qt) * 1024 + gch;
#pragma unroll
                for (int j = 0; j < 16; ++j) gpre[j] = gp[(size_t)j * 1024];
            }
            {
                float P = 1.f, H = 0.f;
#pragma unroll
                for (int j = 0; j < 16; ++j) { const int tt = 16 * qt + j; const float a = as[tt * 68 + ch]; H = a * H + us[tt * 68 + ch]; P *= a; }
                part[(qt * 64 + ch) * 2] = P; part[(qt * 64 + ch) * 2 + 1] = H;
            }
            __syncthreads();
            if (MODE == 0) {
                if (qt == 0) {
                    float Pt = 1.f, Ht = 0.f;
#pragma unroll
                    for (int q = 0; q < 4; ++q) { const float Pq = part[(q * 64 + ch) * 2], Hq = part[(q * 64 + ch) * 2 + 1]; Ht = Pq * Ht + Hq; Pt *= Pq; }
                    const size_t o = (size_t)((b * 64 + c) * 1024 + gch);
                    PEND[o] = Pt; HEND[o] = Ht;
                }
            } else {
                float h = cin[(c & 1) * 64 + ch], hs = 0.f;
#pragma unroll
                for (int q = 0; q < 4; ++q) { if (q == qt) hs = h; const float Pq = part[(q * 64 + ch) * 2], Hq = part[(q * 64 + ch) * 2 + 1]; h = Pq * h + Hq; }
                if (qt == 0) cin[((c + 1) & 1) * 64 + ch] = h;
                h = hs;
                u16* gp = gt + (size_t)(b * T + t0 + 16 * qt) * 1024 + gch;
#pragma unroll
                for (int j = 0; j < 16; ++j) {
                    const int tt = 16 * qt + j;
                    h = as[tt * 68 + ch] * h + us[tt * 68 + ch];
                    gp[(size_t)j * 1024] = f2bf(h * bf2f(gpre[j]));
                }
            }
            __syncthreads();
        }
    }
}

__device__ __forceinline__ unsigned wave_suffix_sum(unsigned x, int lane) {
    unsigned v = x;
    v += (unsigned)__builtin_amdgcn_update_dpp(0, (int)v, 0x101, 0xf, 0xf, false);
    v += (unsigned)__builtin_amdgcn_update_dpp(0, (int)v, 0x102, 0xf, 0xf, false);
    v += (unsigned)__builtin_amdgcn_update_dpp(0, (int)v, 0x104, 0xf, 0xf, false);
    v += (unsigned)__builtin_amdgcn_update_dpp(0, (int)v, 0x108, 0xf, 0xf, false);
    const unsigned t1 = (unsigned)__builtin_amdgcn_readlane((int)v, 16), t2 = (unsigned)__builtin_amdgcn_readlane((int)v, 32), t3 = (unsigned)__builtin_amdgcn_readlane((int)v, 48);
    const int row = lane >> 4;
    return v + ((row == 0) ? (t1 + t2 + t3) : (row == 1) ? (t2 + t3) : (row == 2) ? t3 : 0u);
}
__device__ __forceinline__ void hist_find(LAS unsigned* hist, int lane, unsigned target, unsigned& bin, unsigned& above, unsigned& nbin) {
    asm volatile("s_waitcnt lgkmcnt(0)" ::: "memory");
    unsigned s = 0;
#pragma unroll
    for (int i = 0; i < 8; ++i) { const u32x4 a = *(const LAS u32x4*)(hist + 32 * lane + 4 * i); s += a.x + a.y + a.z + a.w; }
    const unsigned inc = wave_suffix_sum(s, lane);
    const u64 bal = __ballot(inc >= target);
    const int ls = 63 - __builtin_clzll(bal);
    const unsigned incn = (unsigned)__builtin_amdgcn_readlane((int)inc, (ls + 1) & 63);
    const unsigned ab = (ls == 63) ? 0u : incn;
    const unsigned t = (lane < 32) ? hist[32 * ls + lane] : 0u;
    const unsigned inc2 = wave_suffix_sum(t, lane);
    const u64 bal2 = __ballot(lane < 32 && ab + inc2 >= target);
    const int is = 63 - __builtin_clzll(bal2);
    const unsigned inc2n = (unsigned)__builtin_amdgcn_readlane((int)inc2, (is + 1) & 63);
    above = ab + ((is == 31) ? 0u : inc2n);
    bin = (unsigned)(32 * ls + is);
    nbin = (unsigned)__builtin_amdgcn_readlane((int)t, is);
    asm volatile("" ::: "memory");
#pragma unroll
    for (int i = 0; i < 8; ++i) *(LAS u32x4*)(hist + 256 * i + 4 * lane) = (u32x4){0u, 0u, 0u, 0u};
    asm volatile("s_waitcnt lgkmcnt(0)" ::: "memory");
}
#define HIST_ADD(ptr) (void)__hip_atomic_fetch_add((ptr), 1u, __ATOMIC_RELAXED, __HIP_MEMORY_SCOPE_WAVEFRONT)

__device__ void indexer_phase(const Params& p, LAS unsigned char* L, int reps) {
    const int tid = threadIdx.x, wid = tid >> 6, lane = tid & 63, fr = lane & 15, fq = lane >> 4, G = gridDim.x;
    unsigned char* ws = p.ws;
    float* slab = (float*)(ws + WS_SLAB) + (size_t)blockIdx.x * 16 * 4096;
    const u16* iq = (const u16*)(ws + WS_IQ); const u16* ikn = (const u16*)(ws + WS_IKN); const float* ikw = (const float*)(ws + WS_IKW);
    u64* maskT = (u64*)(ws + WS_MASK);
    const float idx_scale = 0.04419417382f;
    LAS unsigned* hist = (LAS unsigned*)(L + wid * 8192);
#pragma unroll
    for (int i = 0; i < 8; ++i) *(LAS u32x4*)(hist + 256 * i + 4 * lane) = (u32x4){0u, 0u, 0u, 0u};
    for (int k = 0; k * G < 1920 * reps; ++k) {
        int u = k * G + ((k & 1) ? (G - 1 - (int)blockIdx.x) : (int)blockIdx.x);
        if (u >= 1920 * reps) continue;
        if (u >= 1920) u -= 1920;
        const int c = 63 - (u >> 5), b = (u >> 2) & 7, qg = u & 3, tok0 = b * T + 64 * c + 16 * qg;
        bf16x8 yq[8][2]; float wq[8];
#pragma unroll
        for (int h = 0; h < 8; ++h) {
#pragma unroll
            for (int ks = 0; ks < 2; ++ks) yq[h][ks] = *(const bf16x8*)(iq + (size_t)(tok0 + fr) * 512 + h * 64 + 32 * ks + 8 * fq);
            wq[h] = ikw[(size_t)(tok0 + fr) * 72 + 64 + h];
        }
        const int ntile = 4 * (c + 1);
#pragma unroll 1
        for (int rpA = 0; rpA < 1 + ((p.dbl >> 12) & 1); ++rpA) {
            const u16* kbase = ikn + (size_t)(b * T + fr) * 64 + 8 * fq;
            int tile = wid;
            bool two = (tile + 8) < ntile;
            bf16x8 x00, x01, x10, x11;
            if (tile < ntile) {
                const u16* kp0 = kbase + (size_t)tile * 1024; const u16* kp1 = kp0 + (two ? 8192 : 0);
                x00 = *(const bf16x8*)kp0; x01 = *(const bf16x8*)(kp0 + 32); x10 = *(const bf16x8*)kp1; x11 = *(const bf16x8*)(kp1 + 32);
            }
            while (tile < ntile) {
                const int ntl = tile + 16; const bool ntwo = (ntl + 8) < ntile;
                bf16x8 y00, y01, y10, y11;
                {
                    const int nt0 = (ntl < ntile) ? ntl : tile;
                    const u16* kp0 = kbase + (size_t)nt0 * 1024; const u16* kp1 = kp0 + (ntwo ? 8192 : 0);
                    y00 = *(const bf16x8*)kp0; y01 = *(const bf16x8*)(kp0 + 32); y10 = *(const bf16x8*)kp1; y11 = *(const bf16x8*)(kp1 + 32);
                }
                f32x4 s0 = {0.f, 0.f, 0.f, 0.f}, s1 = {0.f, 0.f, 0.f, 0.f};
#pragma unroll
                for (int h = 0; h < 8; ++h) {
                    f32x4 a0 = {0.f, 0.f, 0.f, 0.f}, a1 = {0.f, 0.f, 0.f, 0.f};
                    a0 = __builtin_amdgcn_mfma_f32_16x16x32_bf16(x00, yq[h][0], a0, 0, 0, 0); a0 = __builtin_amdgcn_mfma_f32_16x16x32_bf16(x01, yq[h][1], a0, 0, 0, 0);
                    a1 = __builtin_amdgcn_mfma_f32_16x16x32_bf16(x10, yq[h][0], a1, 0, 0, 0); a1 = __builtin_amdgcn_mfma_f32_16x16x32_bf16(x11, yq[h][1], a1, 0, 0, 0);
#pragma unroll
                    for (int r = 0; r < 4; ++r) { s0[r] += wq[h] * fmaxf(a0[r], 0.f); s1[r] += wq[h] * fmaxf(a1[r], 0.f); }
                }
                *(f32x4*)(slab + fr * 4096 + 16 * tile + 4 * fq) = s0 * idx_scale;
                if (two) *(f32x4*)(slab + fr * 4096 + 16 * (tile + 8) + 4 * fq) = s1 * idx_scale;
                x00 = y00; x01 = y01; x10 = y10; x11 = y11; tile = ntl; two = ntwo;
            }
        }
        __syncthreads();
        const int R = c + 1;
#pragma unroll 1
        for (int qi = 0; qi < 2 * (1 + ((p.dbl >> 13) & 1)); ++qi) {
            const int q = 2 * wid + (qi & 1);
            const float* row = slab + q * 4096 + lane;
            unsigned key[64];
            {
                float raw[64];
#pragma unroll
                for (int gI = 0; gI < 4; ++gI) {
                    if (R > 16 * gI) {
#pragma unroll
                        for (int r = 16 * gI; r < 16 * gI + 16; ++r) raw[r] = row[64 * r];
                    } else {
#pragma unroll
                        for (int r = 16 * gI; r < 16 * gI + 16; ++r) raw[r] = 0.f;
                    }
                }
#pragma unroll
                for (int r = 0; r < 64; ++r) {
                    const unsigned bts = __float_as_uint(raw[r] + 0.0f);
                    key[r] = (r < R) ? ((bts & 0x80000000u) ? ~bts : (bts | 0x80000000u)) : 0u;
                }
            }
            unsigned b1, ab1, n1, b2, ab2, n2, b3, ab3, n3;
#pragma unroll
            for (int gI = 0; gI < 4; ++gI)
                if (R > 16 * gI) {
#pragma unroll
                    for (int r = 16 * gI; r < 16 * gI + 16; ++r) if (r < R) HIST_ADD(hist + (key[r] >> 21));
                }
            hist_find(hist, lane, 256u, b1, ab1, n1);
#pragma unroll
            for (int gI = 0; gI < 4; ++gI)
                if (R > 16 * gI) {
#pragma unroll
                    for (int r = 16 * gI; r < 16 * gI + 16; ++r) if ((key[r] >> 21) == b1) HIST_ADD(hist + ((key[r] >> 10) & 2047u));
                }
            hist_find(hist, lane, 256u - ab1, b2, ab2, n2);
            const unsigned pre22 = (b1 << 11) | b2;
            unsigned thr; int need;
            if (256u - ab1 - ab2 == n2) {
                thr = pre22 << 10; need = 1 << 30; b3 = 0u; ab3 = 0u; n3 = 0u;
            } else {
#pragma unroll
                for (int gI = 0; gI < 4; ++gI)
                    if (R > 16 * gI) {
#pragma unroll
                        for (int r = 16 * gI; r < 16 * gI + 16; ++r) if ((key[r] >> 10) == pre22) HIST_ADD(hist + (key[r] & 1023u));
                    }
                hist_find(hist, lane, 256u - ab1 - ab2, b3, ab3, n3);
                thr = (pre22 << 10) | b3;
                need = 256 - (int)(ab1 + ab2 + ab3);
                if (need == (int)n3) need = 1 << 30;
            }
            u64 myword = 0ull;
            if (need >= (1 << 29)) {
#pragma unroll
                for (int gI = 0; gI < 4; ++gI)
                    if (R > 16 * gI) {
#pragma unroll
                        for (int r = 16 * gI; r < 16 * gI + 16; ++r) { const u64 sel = __ballot(key[r] >= thr); if (lane == r) myword = sel; }
                    }
            } else {
                const u64 lt = (1ull << lane) - 1ull;
#pragma unroll
                for (int r = 0; r < 64; ++r) {
                    const bool iseq = key[r] == thr;
                    const u64 eq = __ballot(iseq);
                    const int pre = __popcll(eq & lt);
                    const u64 sel = __ballot(key[r] > thr || (iseq && pre < need));
                    need -= __popcll(eq);
                    if (lane == r) myword = sel;
                }
            }
            if (lane < R) maskT[(((size_t)(b * 64 + c)) * 64 + lane) * 64 + 16 * qg + q] = myword;
        }
        __syncthreads();
    }
}

template <int CUR>
__device__ __forceinline__ void attn_step(LAS unsigned char* L, const int kt, const int c, const int fr, const int fq, const u16* kg, const u16* vg, const u64* mrow,
                                          const bf16x8 (&qf)[2][2], f32x4 (&SC)[4][2], f32x4 (&SN)[4][2], f32x4 (&O)[4][2], float (&lrun)[2], u32x4& kreg, u32x4& vreg, u64 (&mwn)[2],
                                          const int skey, const int sdg) {
    LAS unsigned char* Kn = L + (1 - CUR) * 18432;
    LAS unsigned char* Vc = L + CUR * 18432 + 9216;
    const u64 mw[2] = {(c >= 4) ? mwn[0] : ~0ull, (c >= 4) ? mwn[1] : ~0ull};
    {
        const int k2 = (kt + 2 < c) ? kt + 2 : c, k1 = (kt < c) ? kt + 1 : c;
        kreg = *(const u32x4*)(kg + (size_t)k2 * 64 * 256); vreg = *(const u32x4*)(vg + k1 * 64);
#pragma unroll
        for (int n = 0; n < 2; ++n) mwn[n] = mrow[(size_t)k1 * 64 + 16 * n];
    }
#pragma unroll
    for (int m = 0; m < 4; ++m) {
        const bf16x8 kf0 = *(const LAS bf16x8*)(Kn + ((16 * m + fr) * 72 + 8 * fq) * 2), kf1 = *(const LAS bf16x8*)(Kn + ((16 * m + fr) * 72 + 32 + 8 * fq) * 2);
#pragma unroll
        for (int n = 0; n < 2; ++n) {
            f32x4 z = {0.f, 0.f, 0.f, 0.f};
            z = __builtin_amdgcn_mfma_f32_16x16x32_bf16(kf0, qf[n][0], z, 0, 0, 0);
            SN[m][n] = __builtin_amdgcn_mfma_f32_16x16x32_bf16(kf1, qf[n][1], z, 0, 0, 0);
        }
    }
#pragma unroll
    for (int n = 0; n < 2; ++n) {
        const u64 ms = mw[n] >> (4 * fq);
        const int mlo = (int)(unsigned)ms, mhi = (int)(unsigned)(ms >> 32);
        float psum = 0.f;
#pragma unroll
        for (int m = 0; m < 4; ++m)
#pragma unroll
            for (int r = 0; r < 4; ++r) {
                int keep; asm("v_bfe_i32 %0, %1, %2, 1" : "=v"(keep) : "v"((m < 2) ? mlo : mhi), "n"(16 * (m & 1) + r));
                const float pv = __uint_as_float(__float_as_uint(__builtin_amdgcn_exp2f(SC[m][n][r])) & (unsigned)keep);
                SC[m][n][r] = pv; psum += pv;
            }
        lrun[n] += psum;
    }
#pragma unroll
    for (int kk = 0; kk < 2; ++kk) {
        bf16x8 pf[2];
#pragma unroll
        for (int n = 0; n < 2; ++n) {
            u32x4 w; w.x = pk2(SC[2 * kk][n][0], SC[2 * kk][n][1]); w.y = pk2(SC[2 * kk][n][2], SC[2 * kk][n][3]);
            w.z = pk2(SC[2 * kk + 1][n][0], SC[2 * kk + 1][n][1]); w.w = pk2(SC[2 * kk + 1][n][2], SC[2 * kk + 1][n][3]);
            pf[n] = as_bf16x8(w);
        }
#pragma unroll
        for (int md = 0; md < 4; ++md) {
            const u32x2 v0 = *(const LAS u32x2*)(Vc + ((16 * md + fr) * 72 + 32 * kk + 4 * fq) * 2), v1 = *(const LAS u32x2*)(Vc + ((16 * md + fr) * 72 + 32 * kk + 16 + 4 * fq) * 2);
            u32x4 w; w.x = v0.x; w.y = v0.y; w.z = v1.x; w.w = v1.y;
            const bf16x8 vf = as_bf16x8(w);
#pragma unroll
            for (int n = 0; n < 2; ++n) O[md][n] = __builtin_amdgcn_mfma_f32_16x16x32_bf16(vf, pf[n], O[md][n], 0, 0, 0);
        }
    }
    *(LAS u32x4*)(L + CUR * 18432 + (skey * 72 + sdg * 8) * 2) = kreg;
    *(LAS u32x4*)(L + (1 - CUR) * 18432 + 9216 + (skey * 72 + sdg * 8) * 2) = vreg;
    __syncthreads();
}

__device__ void attn_phase(const Params& p, LAS unsigned char* L, int reps) {
    const int tid = threadIdx.x, wid = tid >> 6, lane = tid & 63, fr = lane & 15, fq = lane >> 4, G = gridDim.x;
    const int hql = wid >> 1, half = wid & 1;
    unsigned char* ws = p.ws;
    const u16* qb = (const u16*)(ws + WS_QB); u16* yo = (u16*)(ws + WS_HB); const u16* kb = (const u16*)(ws + WS_KB); const u16* vT = (const u16*)(ws + WS_VT);
    const u64* maskT = (const u64*)(ws + WS_MASK);
    const int skey = tid >> 3, sdg = tid & 7;
    for (int k = 0; k * G < 2048 * reps; ++k) {
        int u = k * G + ((k & 1) ? (G - 1 - (int)blockIdx.x) : (int)blockIdx.x);
        if (u >= 2048 * reps) continue;
        u &= 2047;
        const int c = 63 - (u >> 5), b = (u >> 2) & 7, g = u & 3, hq = g * 4 + hql;
        const int tokq = b * T + 64 * c + 32 * half;
        bf16x8 qf[2][2];
#pragma unroll
        for (int n = 0; n < 2; ++n)
#pragma unroll
            for (int ks = 0; ks < 2; ++ks) qf[n][ks] = *(const bf16x8*)(qb + (size_t)(tokq + 16 * n + fr) * 1024 + hq * 64 + 32 * ks + 8 * fq);
        f32x4 O[4][2], SA[4][2], SB[4][2];
#pragma unroll
        for (int md = 0; md < 4; ++md)
#pragma unroll
            for (int n = 0; n < 2; ++n) O[md][n] = (f32x4){0.f, 0.f, 0.f, 0.f};
        float lrun[2] = {0.f, 0.f};
        const u16* kg = kb + (size_t)(b * T + skey) * 256 + g * 64 + sdg * 8;
        const u16* vg = vT + ((size_t)((b * 4 + g) * 64 + skey)) * T + sdg * 8;
        const u64* mrow = maskT + (((size_t)(b * 64 + c)) * 64) * 64 + 32 * half + fr;
        u64 mwn[2];
        u32x4 kreg, vreg;
        {
            const u32x4 k0 = *(const u32x4*)kg;
            kreg = *(const u32x4*)(kg + (size_t)((c >= 1) ? 1 : 0) * 64 * 256); vreg = *(const u32x4*)vg;
#pragma unroll
            for (int n = 0; n < 2; ++n) mwn[n] = mrow[16 * n];
            *(LAS u32x4*)(L + (skey * 72 + sdg * 8) * 2) = k0;
            __syncthreads();
#pragma unroll
            for (int m = 0; m < 4; ++m) {
                const bf16x8 kf0 = *(const LAS bf16x8*)(L + ((16 * m + fr) * 72 + 8 * fq) * 2), kf1 = *(const LAS bf16x8*)(L + ((16 * m + fr) * 72 + 32 + 8 * fq) * 2);
#pragma unroll
                for (int n = 0; n < 2; ++n) {
                    f32x4 z = {0.f, 0.f, 0.f, 0.f};
                    z = __builtin_amdgcn_mfma_f32_16x16x32_bf16(kf0, qf[n][0], z, 0, 0, 0);
                    SA[m][n] = __builtin_amdgcn_mfma_f32_16x16x32_bf16(kf1, qf[n][1], z, 0, 0, 0);
                }
            }
            *(LAS u32x4*)(L + 18432 + (skey * 72 + sdg * 8) * 2) = kreg;
            *(LAS u32x4*)(L + 9216 + (skey * 72 + sdg * 8) * 2) = vreg;
            __syncthreads();
        }
        for (int kt0 = 0; kt0 <= c; kt0 += 2) {
            attn_step<0>(L, kt0, c, fr, fq, kg, vg, mrow, qf, SA, SB, O, lrun, kreg, vreg, mwn, skey, sdg);
            if (kt0 + 1 <= c) attn_step<1>(L, kt0 + 1, c, fr, fq, kg, vg, mrow, qf, SB, SA, O, lrun, kreg, vreg, mwn, skey, sdg);
        }
#pragma unroll
        for (int n = 0; n < 2; ++n) {
            float l = lrun[n]; l += __shfl_xor(l, 16); l += __shfl_xor(l, 32);
            const float inv = 1.0f / l;
#pragma unroll
            for (int md = 0; md < 4; ++md) {
                const f32x4 o = O[md][n] * inv;
                u32x2 w; w.x = pk2(o[0], o[1]); w.y = pk2(o[2], o[3]);
                *(u32x2*)(yo + (size_t)(tokq + 16 * n + fr) * 1024 + hq * 64 + 16 * md + 4 * fq) = w;
            }
        }
    }
}

__device__ __noinline__ void grid_barrier_nv(unsigned* bar, unsigned x, volatile LAS unsigned* st) { XcdBarrier b; b.bar = bar; b.x = x; b.st = st; xcd_barrier(b); }
#define grid_barrier(B) grid_barrier_nv((B).bar, (B).x, (B).st)
__global__ void __launch_bounds__(512, 2) fwd_megakernel(Params p) {
    extern __shared__ __attribute__((aligned(16))) unsigned char shm[];
    LAS unsigned char* L = (LAS unsigned char*)shm;
    cg::grid_group grid = cg::this_grid();
    unsigned char* ws = p.ws;
    u16* gb = (u16*)p.out;
    volatile LAS unsigned* xst = (volatile LAS unsigned*)(L + 131072);
    if (threadIdx.x == 0) { xst[0] = 0u; xst[1] = 0u; xst[2] = 0u; xst[3] = 0u; }
    __syncthreads();
    const XcdBarrier xb = xcd_barrier_post((unsigned*)(ws + WS_BAR), xst);
#define PHASE(i) if (p.ph_lo <= (i) && (i) < p.ph_hi)
#define SEAM(i) if (p.ph_lo <= (i) && (i) + 1 < p.ph_hi) { if ((i) == 0 && p.pad_) grid.sync(); else grid_barrier(xb); }
#define REPS(bit) (1 + ((p.dbl >> (bit)) & 1))
    PHASE(0) { for (int rp0 = 0; rp0 < REPS(0); ++rp0) prepass(p); }
    SEAM(0);
    PHASE(1) {
        EpiG1 E; E.rx = (u16*)(ws + WS_RX); E.gt = (u16*)(ws + WS_GT); E.qb = (u16*)(ws + WS_QB); E.kb = (u16*)(ws + WS_KB); E.vb = (u16*)(ws + WS_VB); E.iq = (u16*)(ws + WS_IQ); E.gb = gb;
        E.ikw = (float*)(ws + WS_IKW); E.gate_b = p.in[I_GATEB];
        run_gemm(L, (const u16*)(ws + WS_HB), (const u16*)(ws + WS_WT_IN), NIN, 1024, E, REPS(1));
    }
    SEAM(1);
    PHASE(2) { rnn_phase<0>(p, L, REPS(2)); norm_phase(p); }
    SEAM(2);
    PHASE(3) { rnn_phase<1>(p, L, 1); indexer_phase(p, L, REPS(5)); }
    SEAM(3);
    PHASE(4) { attn_phase(p, L, REPS(6)); }
    SEAM(4);
    PHASE(5) {
        EpiGate2 E; E.O = (u16*)(ws + WS_RX); E.gb = gb;
        run_gemm2(L, (const u16*)(ws + WS_GT), (const u16*)(ws + WS_WT_ORNN), (const u16*)(ws + WS_HB), (const u16*)(ws + WS_WT_OATT), 1024, 1024, E);
    }
    SEAM(5);
    PHASE(6) {
        EpiRes1 E; E.x = p.in[I_X]; E.out = p.out; E.xw = (u16*)(ws + WS_XW); E.n2w = p.in[I_N2W]; E.rowss = (float*)(ws + WS_ROWSS);
        run_gemm(L, (const u16*)(ws + WS_RX), (const u16*)(ws + WS_WT_OUT), 1024, 1024, E);
    }
    SEAM(6);
    PHASE(7) {
        EpiFF1 E; E.hid = (u16*)(ws + WS_HID); E.rowss = (const float*)(ws + WS_ROWSS);
        run_gemm(L, (const u16*)(ws + WS_XW), (const u16*)(ws + WS_WT_FFIN), DFF, 1024, E, REPS(10));
    }
    SEAM(7);
    PHASE(8) {
        EpiRes2 E; E.out = p.out;
        run_gemm(L, (const u16*)(ws + WS_HID), (const u16*)(ws + WS_WT_FFOUT), 1024, DFF, E);
    }
#undef REPS
#undef PHASE
#undef SEAM
}

extern "C" void kernel_launch(void* const* d_in, const int* in_sizes, int n_in, void* d_out, int out_size, void* d_ws, size_t ws_size, hipStream_t stream) {
    static int grid_blocks = 0;
    if (grid_blocks == 0) {
        if (n_in != 20 || out_size != M * D || ws_size < WS_END) { fprintf(stderr, "kernel_launch: unexpected shapes (n_in %d out %d ws %zu)\n", n_in, out_size, ws_size); grid_blocks = -1; return; }
        int dev = 0, cus = 0, per_cu = 0;
        (void)hipGetDevice(&dev);
        (void)hipDeviceGetAttribute(&cus, hipDeviceAttributeMultiprocessorCount, dev);
        (void)hipFuncSetAttribute((const void*)fwd_megakernel, hipFuncAttributeMaxDynamicSharedMemorySize, LDS_BYTES);
        (void)hipOccupancyMaxActiveBlocksPerMultiprocessor(&per_cu, (const void*)fwd_megakernel, 512, LDS_BYTES);
        if (per_cu < 1) { fprintf(stderr, "kernel_launch: occupancy query says %d blocks per CU\n", per_cu); per_cu = 1; }
        grid_blocks = cus;
        fprintf(stderr, "kernel_launch: cus %d per_cu %d grid %d\n", cus, per_cu, grid_blocks);
    }
    if (grid_blocks < 0) return;
    Params p{};
    for (int i = 0; i < 20; ++i) p.in[i] = (const float*)d_in[i];
    p.out = (float*)d_out; p.ws = (unsigned char*)d_ws; p.ph_lo = 0; p.ph_hi = 9; p.dbl = PROBE_DBL;
    (void)hipMemsetAsync((unsigned char*)d_ws + WS_BAR, 0, XCD_BAR_WORDS * sizeof(unsigned), stream);
    void* args[] = {&p};
    hipError_t e = hipLaunchCooperativeKernel((const void*)fwd_megakernel, dim3(grid_blocks), dim3(512), args, LDS_BYTES, stream);
    if (e != hipSuccess) fprintf(stderr, "cooperative launch failed: %s (grid %d)\n", hipGetErrorString(e), grid_blocks);
}
```

```cpp
#include <hip/hip_runtime.h>
#include <hip/hip_cooperative_groups.h>
#include <cstdio>
#define PROBE_DBL 0
namespace pg8 {
#define PG8_LAS __attribute__((address_space(3)))
typedef unsigned short bf16_t;
typedef short bf16x8 __attribute__((ext_vector_type(8)));
typedef float f32x4 __attribute__((ext_vector_type(4)));
typedef unsigned u32x4 __attribute__((ext_vector_type(4)));
constexpr int BM = 256, BK = 64, HALF = 128, HTB = HALF * BK * 2  , STAGE_BYTES = 8 * HTB, NXCD = 8, WGM = 8;

__host__ __device__ __forceinline__ int lds_byte(int r, int c) { const int st = (r >> 4) * 2 + (c >> 5), rr = r & 15, cc = c & 31, ob = rr * 64 + cc * 2; return st * 1024 + (ob ^ (((ob >> 9) & 1) << 5)); }
__host__ __device__ __forceinline__ void stage_rc(int b, int& R, int& C) { const int st = b / 1024, sb = b % 1024, swz = sb ^ (((sb >> 9) & 1) << 5); R = (st >> 1) * 16 + swz / 64; C = (st & 1) * 32 + (swz % 64) / 2; }
__host__ __device__ __forceinline__ int perm32(int rho) { const int n = rho >> 4, i = rho & 15; return 8 * (i >> 2) + 4 * n + (i & 3); }

struct Unit { int pm, pn, seg; };
struct Gemm { const bf16_t* A; const bf16_t* Bt; int M, N, K; const bf16_t* A2; const bf16_t* Bt2; };

struct StaticOrder {
    int nM, nN, nwg, G, c, reps = 1, segs = 1;
    __host__ __device__ void init(int M, int N, int G_, int c_) { nM = M / BM; nN = N / BM; nwg = nM * nN; G = G_; c = c_; }
    __host__ __device__ bool next(int i, Unit& u) const {
        const int ii = i / segs; u.seg = i - ii * segs;
        const long L = (long)ii * G + c; if (L >= (long)nwg * reps) return false;
        int wgid = (int)(L % nwg); { const int q = nwg / NXCD, r = nwg % NXCD, xcd = wgid % NXCD, off = wgid / NXCD; wgid = (xcd < r ? xcd * (q + 1) : r * (q + 1) + (xcd - r) * q) + off; }
        const int nig = WGM * nN, gid = wgid / nig, fm = gid * WGM, gsz = (nM - fm) < WGM ? (nM - fm) : WGM;
        u.pm = fm + ((wgid % nig) % gsz); u.pn = (wgid % nig) / gsz; return true;
    }
    __device__ __forceinline__ void a_ready(const Unit&) const {}
    __device__ __forceinline__ void done(const Unit&) const {}
};
__device__ __forceinline__ unsigned cvt_pk_bf16(float lo, float hi) { unsigned r; asm volatile("v_cvt_pk_bf16_f32 %0, %1, %2" : "=v"(r) : "v"(lo), "v"(hi)); return r; }
typedef float f32x2 __attribute__((ext_vector_type(2)));

template <class Epi, class Sched, bool STAMP = false>
__device__ __forceinline__ void gemm_phase(PG8_LAS unsigned char* lds, const Gemm g, const Sched& S, const Epi& E, unsigned long long* stamps) {
    const int tid = threadIdx.x, wid = __builtin_amdgcn_readfirstlane(tid >> 6), lane = tid & 63, wr = wid >> 2, wc = wid & 3, fr = lane & 15, fq = lane >> 4;
    const int K = g.K, nt = K / BK;
    int ts_lo = 0, ts_hi = 0, nts = 0; const unsigned long long rt_entry = STAMP ? (unsigned long long)wall_clock64() : 0ull;
#define PG8_STAMP() do { if (STAMP && wid == 0 && nts < 64) { const unsigned long long _c = (unsigned long long)clock64(); \
        ts_lo = (lane == nts) ? (int)(unsigned)_c : ts_lo; ts_hi = (lane == nts) ? (int)(unsigned)(_c >> 32) : ts_hi; ++nts; } } while (0)
    PG8_STAMP();
    unsigned voffA[2], voffB[2];
#pragma unroll
    for (int i = 0; i < 2; ++i) { int R, C; stage_rc(tid * 16 + i * 8192, R, C); const int Rb = Epi::PERM ? ((R & ~31) + perm32(R & 31)) : R;
        voffA[i] = (unsigned)(R * K + C) * 2u; voffB[i] = (unsigned)(Rb * K + C) * 2u; }
    const size_t kstep = (size_t)(BK * 2);
    const size_t hstep = (size_t)HALF * K * 2;
    const size_t tstep = 2 * hstep;
    const unsigned ldsw = (unsigned)wid * 1024u;
    const int aoff = lds_byte(wr * 64 + fr, fq * 8), boff = lds_byte(wc * 32 + fr, fq * 8);
#define PG8_SA(b, h) (((b) * 2 + (h)) * HTB)
#define PG8_SB(b, h) ((4 + (b) * 2 + (h)) * HTB)
#define PG8_STAGE(bufoff, gbase, voff) do { _Pragma("unroll") for (int _i = 0; _i < 2; ++_i) \
        __builtin_amdgcn_global_load_lds((const unsigned*)((const char*)(gbase) + (voff)[_i]), (PG8_LAS unsigned*)(lds + (bufoff) + ldsw + _i * 8192), 16, 0, 0); } while (0)
#define PG8_LDA(dst, b, h) do { _Pragma("unroll") for (int m = 0; m < 4; ++m) _Pragma("unroll") for (int k = 0; k < 2; ++k) dst[m][k] = *(const PG8_LAS bf16x8*)(lds + PG8_SA(b, h) + aoff + m * 2048 + k * 1024); } while (0)
#define PG8_LDB(dst, b, h) do { _Pragma("unroll") for (int n = 0; n < 2; ++n) _Pragma("unroll") for (int k = 0; k < 2; ++k) dst[n][k] = *(const PG8_LAS bf16x8*)(lds + PG8_SB(b, h) + boff + n * 2048 + k * 1024); } while (0)
#define PG8_MMA(ai, bj, At, Bt) do { __builtin_amdgcn_s_setprio(1); _Pragma("unroll") for (int m = 0; m < 4; ++m) _Pragma("unroll") for (int n = 0; n < 2; ++n) _Pragma("unroll") for (int k = 0; k < 2; ++k) \
        acc[ai][bj][m][n] = __builtin_amdgcn_mfma_f32_16x16x32_bf16(Bt[n][k], At[m][k], acc[ai][bj][m][n], 0, 0, 0); __builtin_amdgcn_s_setprio(0); } while (0)
#define PG8_WAIT_V(n) asm volatile("s_waitcnt vmcnt(" #n ")" ::: "memory")
#define PG8_WAIT_L(n) asm volatile("s_waitcnt lgkmcnt(" #n ")" ::: "memory")
#define PG8_BAR __builtin_amdgcn_s_barrier()
#define PG8_SCHED __builtin_amdgcn_sched_barrier(0)
    Unit cur, nxt; int ui = 0;
    if (!S.next(0, cur)) return;
    f32x4 acc[2][2][4][2];
#pragma unroll
    for (int a = 0; a < 2; ++a)
#pragma unroll
        for (int b = 0; b < 2; ++b)
#pragma unroll
            for (int m = 0; m < 4; ++m)
#pragma unroll
                for (int n = 0; n < 2; ++n) acc[a][b][m][n] = (f32x4){0.f, 0.f, 0.f, 0.f};
    bf16x8 At[4][2], B0[2][2], B1[2][2];
    const char* cA = (const char*)(cur.seg ? g.A2 : g.A) + (size_t)cur.pm * tstep; const char* cB = (const char*)(cur.seg ? g.Bt2 : g.Bt) + (size_t)cur.pn * tstep;
    S.a_ready(cur);
    PG8_STAGE(PG8_SB(0, 0), cB, voffB); PG8_STAGE(PG8_SA(0, 0), cA, voffA); PG8_STAGE(PG8_SB(0, 1), cB + hstep, voffB); PG8_STAGE(PG8_SA(0, 1), cA + hstep, voffA);
    if (wr == 1) PG8_BAR;
    PG8_WAIT_V(4); PG8_BAR;
    PG8_STAGE(PG8_SB(1, 0), cB + kstep, voffB); PG8_STAGE(PG8_SA(1, 0), cA + kstep, voffA); PG8_STAGE(PG8_SB(1, 1), cB + hstep + kstep, voffB);
    PG8_WAIT_V(6); PG8_BAR;
    PG8_STAMP();
    for (;;) {
        const bool has_next = S.next(ui + 1, nxt);
        const char* nA = has_next ? (const char*)(nxt.seg ? g.A2 : g.A) + (size_t)nxt.pm * tstep : cA; const char* nB = has_next ? (const char*)(nxt.seg ? g.Bt2 : g.Bt) + (size_t)nxt.pn * tstep : cB;
        for (int t = 0; t < nt; t += 2) {
            const bool last = (t == nt - 2);
            const char* a1 = cA + (size_t)(t + 1) * kstep;
            const char* a2 = last ? nA : cA + (size_t)(t + 2) * kstep; const char* b2 = last ? nB : cB + (size_t)(t + 2) * kstep;
            const char* a3 = a2 + kstep; const char* b3 = b2 + kstep;
            if (last && has_next) S.a_ready(nxt);
            PG8_LDB(B0, 0, 0); PG8_SCHED; PG8_LDA(At, 0, 0); PG8_STAGE(PG8_SA(1, 1), a1 + hstep, voffA);
            PG8_WAIT_L(8); PG8_BAR; PG8_WAIT_L(0); PG8_MMA(0, 0, At, B0); PG8_BAR; PG8_SCHED;
            PG8_LDB(B1, 0, 1); PG8_STAGE(PG8_SB(0, 0), b2, voffB);
            PG8_BAR; PG8_WAIT_L(0); PG8_MMA(0, 1, At, B1); PG8_BAR;
            PG8_LDA(At, 0, 1); PG8_STAGE(PG8_SA(0, 0), a2, voffA);
            PG8_BAR; PG8_WAIT_L(0); PG8_MMA(1, 0, At, B0); PG8_BAR; PG8_SCHED;
            PG8_STAGE(PG8_SB(0, 1), b2 + hstep, voffB);
            PG8_WAIT_V(6); PG8_BAR; PG8_MMA(1, 1, At, B1); PG8_BAR;
            PG8_LDB(B0, 1, 0); PG8_SCHED; PG8_LDA(At, 1, 0); PG8_STAGE(PG8_SA(0, 1), a2 + hstep, voffA);
            PG8_WAIT_L(8); PG8_BAR; PG8_WAIT_L(0); PG8_MMA(0, 0, At, B0); PG8_BAR; PG8_SCHED;
            PG8_LDB(B1, 1, 1); PG8_STAGE(PG8_SB(1, 0), b3, voffB);
            PG8_BAR; PG8_WAIT_L(0); PG8_MMA(0, 1, At, B1); PG8_BAR;
            PG8_LDA(At, 1, 1); PG8_STAGE(PG8_SA(1, 0), a3, voffA);
            PG8_BAR; PG8_WAIT_L(0); PG8_MMA(1, 0, At, B0); PG8_BAR; PG8_SCHED;
            PG8_STAGE(PG8_SB(1, 1), b3 + hstep, voffB);
            PG8_WAIT_V(6); PG8_BAR; PG8_MMA(1, 1, At, B1); PG8_BAR;
        }
        PG8_STAMP();
        bool keep_acc = false;
        if constexpr (Epi::TWOSEG) { if (cur.seg == 0) { E.mid(acc, cur, wr, wc, fr, fq); keep_acc = true; } else E(acc, cur, wr, wc, fr, fq); }
        else if constexpr (!Epi::AFTER_DRAIN) { E(acc, cur, wr, wc, fr, fq); S.done(cur); }
        PG8_STAMP();
        if (!has_next) break;
        if (!keep_acc)
#pragma unroll
        for (int a = 0; a < 2; ++a)
#pragma unroll
            for (int b = 0; b < 2; ++b)
#pragma unroll
                for (int m = 0; m < 4; ++m)
#pragma unroll
                    for (int n = 0; n < 2; ++n) acc[a][b][m][n] = (f32x4){0.f, 0.f, 0.f, 0.f};
        cur = nxt; cA = nA; cB = nB; ++ui;
    }
    PG8_WAIT_V(0);
    if (wr == 0) PG8_BAR;
    PG8_BAR;
    if constexpr (Epi::AFTER_DRAIN) { E.fused(acc, cur, wr, wc, fr, fq, lds, wid, lane); S.done(cur); }
    PG8_STAMP();
    if (STAMP && wid == 0) { stamps[lane] = lane < nts ? (((unsigned long long)(unsigned)ts_hi << 32) | (unsigned)ts_lo) : 0ull;
        if (lane == 62) stamps[62] = rt_entry; if (lane == 63) stamps[63] = (unsigned long long)wall_clock64(); }
#undef PG8_STAMP
#undef PG8_SA
#undef PG8_SB
#undef PG8_STAGE
#undef PG8_LDA
#undef PG8_LDB
#undef PG8_MMA
#undef PG8_WAIT_V
#undef PG8_WAIT_L
#undef PG8_BAR
#undef PG8_SCHED
}
}

namespace cg = cooperative_groups;
typedef unsigned short u16;
typedef pg8::f32x4 f32x4;
typedef pg8::bf16x8 bf16x8;
typedef pg8::u32x4 u32x4;
typedef unsigned u32x2 __attribute__((ext_vector_type(2)));
typedef unsigned long long u64;
#define LAS PG8_LAS
#define XB_TMO      128
#define XB_XCNT(j)  (256  + 64 * (j))
#define XB_XSUB(j)  (1280 + 64 * (j))
#define XB_XGEN(j)  (2304 + 64 * (j))
#define XB_TOP      3328
#define XB_TOPGEN   3392
#define XCD_BAR_WORDS 3456
#define XB_SPIN_CAP (1u << 18)

__device__ __forceinline__ unsigned xb_ld(unsigned* p)              { return __hip_atomic_load(p, __ATOMIC_RELAXED, __HIP_MEMORY_SCOPE_AGENT); }
__device__ __forceinline__ unsigned xb_add(unsigned* p, unsigned v) { return __hip_atomic_fetch_add(p, v, __ATOMIC_RELAXED, __HIP_MEMORY_SCOPE_AGENT); }
__device__ __forceinline__ unsigned xb_xcc_id() { return (unsigned)__builtin_amdgcn_s_getreg((3 << 11) | 20) & 0xFu; }
#define XB_SPIN(cond, bar) do { unsigned _sp = 0; while (cond) { __builtin_amdgcn_s_sleep(1); \
    if ((++_sp & 255u) == 0u) { if (xb_ld(&(bar)[XB_TMO])) break; if (_sp > XB_SPIN_CAP) { atomicAdd(&(bar)[XB_TMO], 1u); break; } } } } while (0)

struct XcdBarrier {
    unsigned* bar; unsigned x;
    volatile LAS unsigned* st;
};

__device__ __forceinline__ XcdBarrier xcd_barrier_post(unsigned* bar, volatile LAS unsigned* st) {
    XcdBarrier b; b.bar = bar; b.x = xb_xcc_id(); b.st = st;
    if (threadIdx.x == 0) (void)xb_add(&bar[XB_XCNT(b.x)], 1u);
    return b;
}
__device__ __forceinline__ void xcd_barrier_complete(unsigned* bar, unsigned x, unsigned& nloc, unsigned& nx) {
    const unsigned G = gridDim.x * gridDim.y * gridDim.z;
    unsigned sum, cnt, mine, sp = 0u;
    for (;;) {
        sum = 0u; cnt = 0u; mine = 0u;
#pragma unroll
        for (unsigned j = 0; j < 16; ++j) { const unsigned c = xb_ld(&bar[XB_XCNT(j)]); sum += c; cnt += (c > 0u) ? 1u : 0u; mine = (j == x) ? c : mine; }
        if (sum == G) break;
        __builtin_amdgcn_s_sleep(1);
        if ((++sp & 255u) == 0u) { if (xb_ld(&bar[XB_TMO])) break; if (sp > XB_SPIN_CAP) { atomicAdd(&bar[XB_TMO], 1u); break; } }
    }
    nloc = mine > 0u ? mine : 1u; nx = cnt > 0u ? cnt : 1u;
}

__device__ __forceinline__ void xcd_barrier(const XcdBarrier& b) {
    asm volatile("s_waitcnt vmcnt(0)" ::: "memory");
    __syncthreads();
    if (threadIdx.x == 0) {
        unsigned* bar = b.bar;
        __builtin_amdgcn_s_waitcnt(0);
        unsigned nloc = b.st[0], nx = b.st[1];
        if (nloc == 0u) { xcd_barrier_complete(bar, b.x, nloc, nx); b.st[0] = nloc; b.st[1] = nx; }
        const unsigned old = xb_add(&bar[XB_XSUB(b.x)], 1u);
        const unsigned gen = old / nloc;
        if (old + 1u == (gen + 1u) * nloc) {
            __builtin_amdgcn_fence(__ATOMIC_RELEASE, "agent");
            asm volatile("s_waitcnt vmcnt(0)" ::: "memory");
            const unsigned og = xb_add(&bar[XB_TOP], 1u);
            const unsigned tg = og / nx;
            if (og + 1u == (tg + 1u) * nx) xb_add(&bar[XB_TOPGEN], 1u);
            else XB_SPIN(xb_ld(&bar[XB_TOPGEN]) == tg, bar);
            __builtin_amdgcn_fence(__ATOMIC_ACQUIRE, "agent");
            xb_add(&bar[XB_XGEN(b.x)], 1u);
            asm volatile("s_waitcnt vmcnt(0)" ::: "memory");
        } else {
            XB_SPIN(xb_ld(&bar[XB_XGEN(b.x)]) == gen, bar);
            __builtin_amdgcn_fence(__ATOMIC_ACQUIRE, "agent");
            asm volatile("s_waitcnt vmcnt(0)" ::: "memory");
        }
    }
    __syncthreads();
}

constexpr int NB = 8, T = 4096, D = 1024, M = NB * T;
constexpr int DIN = 6216, NIN = 6400, DFF = 4096;
constexpr float EPSV = 1e-6f;
constexpr size_t MiB = (size_t)1 << 20;
constexpr size_t WS_WT_IN = 0, WS_WT_ORNN = 13 * MiB, WS_WT_OATT = 15 * MiB, WS_WT_OUT = 17 * MiB, WS_WT_FFIN = 19 * MiB, WS_WT_FFOUT = 27 * MiB;
constexpr size_t WS_WT_GATE = 35 * MiB;
constexpr size_t WS_ROWSS = 35 * MiB + 512 * 1024;
constexpr size_t WS_SPL = 35 * MiB + 768 * 1024;
constexpr size_t WS_PEND = 36 * MiB, WS_HEND = 38 * MiB;
constexpr size_t WS_IKW = 40 * MiB;
constexpr size_t WS_IKN = 49 * MiB;
constexpr size_t WS_KB = 53 * MiB, WS_VB = 69 * MiB, WS_VT = 85 * MiB;
constexpr size_t WS_MASK = 101 * MiB;
constexpr size_t WS_IQ = 117 * MiB;
constexpr size_t WS_SLAB = 149 * MiB;
constexpr size_t WS_HB = 213 * MiB;
constexpr size_t WS_RX = 277 * MiB;
constexpr size_t WS_GT = 341 * MiB;
constexpr size_t WS_QB = 405 * MiB;
constexpr size_t WS_XW = 40 * MiB;
constexpr size_t WS_HID = 117 * MiB;
constexpr size_t WS_END = 469 * MiB;
constexpr int LDS_BYTES = 131072 + 64;
constexpr size_t WS_BAR = 35 * MiB + 832 * 1024;
#ifndef PROBE_DBL
#define PROBE_DBL 0
#endif

struct Params {
    const float* in[20];
    float* out;
    unsigned char* ws;
    int ph_lo, ph_hi, dbl, pad_;
};
enum { I_X = 0, I_N1W, I_WIN, I_CONVW, I_CONVB, I_WA, I_BA, I_WX, I_BX, I_LAM, I_QNW, I_KNW, I_IKNW, I_WORNN, I_WOATT, I_GATEB, I_WOUT, I_N2W, I_WFFIN, I_WFFOUT };

__device__ __forceinline__ unsigned pk2(float a, float b) { return pg8::cvt_pk_bf16(a, b); }
__device__ __forceinline__ u16 f2bf(float f) { return (u16)(pk2(f, 0.f) & 0xffffu); }
__device__ __forceinline__ float bflo(unsigned w) { return __uint_as_float(w << 16); }
__device__ __forceinline__ float bfhi(unsigned w) { return __uint_as_float(w & 0xffff0000u); }
__device__ __forceinline__ float bf2f(u16 v) { return __uint_as_float(((unsigned)v) << 16); }
__device__ __forceinline__ float wave_sum(float v) {
#pragma unroll
    for (int o = 32; o; o >>= 1) v += __shfl_xor(v, o);
    return v;
}
__device__ __forceinline__ float sigmoidf_(float v) { return __builtin_amdgcn_rcpf(1.0f + __expf(-v)); }
__device__ __forceinline__ float gelu_tanh(float x) { const float z = 0.7978845608f * (x + 0.044715f * x * x * x); return x * __builtin_amdgcn_rcpf(1.0f + __expf(-2.0f * z)); }
__device__ __forceinline__ bf16x8 as_bf16x8(u32x4 w) { union { u32x4 a; bf16x8 b; } c; c.a = w; return c.b; }

template <class MapF>
__device__ __forceinline__ void transpose_w(const float* __restrict__ src, int ld, u16* __restrict__ dst, int K, int Nd, MapF map, int gw, int GW, int lane) {
    const int nblk = Nd >> 6, items = nblk * (K >> 3);
    for (int it = gw; it < items; it += GW) {
        const int nb = it % nblk, kb = it / nblk, n = nb * 64 + lane, k0 = kb * 8, col = map(n);
        float v[8];
#pragma unroll
        for (int j = 0; j < 8; ++j) v[j] = col >= 0 ? src[(size_t)(k0 + j) * ld + col] : 0.f;
        u32x4 w; w.x = pk2(v[0], v[1]); w.y = pk2(v[2], v[3]); w.z = pk2(v[4], v[5]); w.w = pk2(v[6], v[7]);
        *(u32x4*)(dst + (size_t)n * K + k0) = w;
    }
}
struct MapIn { __device__ int operator()(int n) const { return n < 4096 ? n : (n < 6144 ? n + 72 : (n < 6216 ? n - 2048 : -1)); } };
struct MapId { __device__ int operator()(int n) const { return n; } };

__device__ void prepass(const Params& p) {
    const int tid = threadIdx.x, lane = tid & 63, gw = blockIdx.x * 8 + (tid >> 6), GW = gridDim.x * 8;
    unsigned char* ws = p.ws;
    {
        const float* x = p.in[I_X]; const float* nw = p.in[I_N1W]; u16* hb = (u16*)(ws + WS_HB);
        const f32x4 w0 = *(const f32x4*)(nw + 8 * lane), w1 = *(const f32x4*)(nw + 8 * lane + 4), w2 = *(const f32x4*)(nw + 512 + 8 * lane), w3 = *(const f32x4*)(nw + 512 + 8 * lane + 4);
        for (int row0 = gw; row0 < M; row0 += 2 * GW) {
            f32x4 a[2][4];
#pragma unroll
            for (int z = 0; z < 2; ++z) {
                const float* xr = x + (size_t)(row0 + z * GW) * D + 8 * lane;
                a[z][0] = *(const f32x4*)xr; a[z][1] = *(const f32x4*)(xr + 4); a[z][2] = *(const f32x4*)(xr + 512); a[z][3] = *(const f32x4*)(xr + 516);
            }
#pragma unroll
            for (int z = 0; z < 2; ++z) {
                float ss = 0.f;
#pragma unroll
                for (int j = 0; j < 4; ++j) ss += a[z][0][j] * a[z][0][j] + a[z][1][j] * a[z][1][j] + a[z][2][j] * a[z][2][j] + a[z][3][j] * a[z][3][j];
                ss = wave_sum(ss);
                const float rs = rsqrtf(ss * (1.0f / 1024.0f) + EPSV);
                const f32x4 a0 = a[z][0] * rs * w0, a1 = a[z][1] * rs * w1, a2 = a[z][2] * rs * w2, a3 = a[z][3] * rs * w3;
                u32x4 o0, o1; o0.x = pk2(a0[0], a0[1]); o0.y = pk2(a0[2], a0[3]); o0.z = pk2(a1[0], a1[1]); o0.w = pk2(a1[2], a1[3]);
                o1.x = pk2(a2[0], a2[1]); o1.y = pk2(a2[2], a2[3]); o1.z = pk2(a3[0], a3[1]); o1.w = pk2(a3[2], a3[3]);
                u16* hr = hb + (size_t)(row0 + z * GW) * D + 8 * lane;
                *(u32x4*)hr = o0; *(u32x4*)(hr + 512) = o1;
            }
        }
    }
    transpose_w(p.in[I_WIN], DIN, (u16*)(ws + WS_WT_IN), 1024, NIN, MapIn(), gw, GW, lane);
    transpose_w(p.in[I_WORNN], 1024, (u16*)(ws + WS_WT_ORNN), 1024, 1024, MapId(), gw, GW, lane);
    transpose_w(p.in[I_WOATT], 1024, (u16*)(ws + WS_WT_OATT), 1024, 1024, MapId(), gw, GW, lane);
    transpose_w(p.in[I_WOUT], 1024, (u16*)(ws + WS_WT_OUT), 1024, 1024, MapId(), gw, GW, lane);
    transpose_w(p.in[I_WFFIN], DFF, (u16*)(ws + WS_WT_FFIN), 1024, DFF, MapId(), gw, GW, lane);
    transpose_w(p.in[I_WFFOUT], 1024, (u16*)(ws + WS_WT_FFOUT), DFF, 1024, MapId(), gw, GW, lane);
    {
        u16* wt = (u16*)(ws + WS_WT_GATE);
        const int gt = blockIdx.x * 512 + tid, GT = gridDim.x * 512;
        for (int i = gt; i < 2 * 65536; i += GT) {
            const int which = i >> 16, r = i & 65535, n = r >> 12, e = (r >> 6) & 63, d = r & 63;
            const float* src = which ? p.in[I_WX] : p.in[I_WA];
            wt[i] = f2bf(src[n * 4096 + d * 64 + e]);
        }
        float* rowss = (float*)(ws + WS_ROWSS);
        for (int i = gt; i < M; i += GT) rowss[i] = 0.f;
        float* spl = (float*)(ws + WS_SPL);
        for (int i = gt; i < 1024; i += GT) spl[i] = -8.0f * log1pf(expf(-p.in[I_LAM][i]));
    }
}

struct EpiG1 {
    static constexpr bool PERM = true, AFTER_DRAIN = false, TWOSEG = false;
    u16 *rx, *gt, *qb, *kb, *vb, *iq, *gb; float* ikw; const float* gate_b;
    __device__ __forceinline__ void operator()(const f32x4 (&acc)[2][2][4][2], const pg8::Unit& u, int wr, int wc, int fr, int fq) const {
        const int row0 = u.pm * 256 + wr * 64 + fr, pn = u.pn, cl = wc * 32 + 8 * fq;
        int mode = 0, ld = 1024; u16* base = rx;
        if (pn < 4) { base = rx + pn * 256; }
        else if (pn < 8) { mode = 1; base = gt + (pn - 4) * 256; }
        else if (pn < 12) { base = qb + (pn - 8) * 256; }
        else if (pn == 12) { base = kb; ld = 256; }
        else if (pn == 13) { base = vb; ld = 256; }
        else if (pn < 16) { base = iq + (pn - 14) * 256; ld = 512; }
        else if (pn < 24) { mode = 2; base = gb + (pn - 16) * 256; ld = 2048; }
        else mode = 3;
        if (mode == 3) {
            if (cl <= 64) {
#pragma unroll
                for (int ai = 0; ai < 2; ++ai)
#pragma unroll
                    for (int m = 0; m < 4; ++m) { float* rp = ikw + (size_t)(row0 + ai * 128 + m * 16) * 72 + cl; *(f32x4*)rp = acc[ai][0][m][0]; *(f32x4*)(rp + 4) = acc[ai][0][m][1]; }
            }
            return;
        }
        f32x4 bv[2][2];
#pragma unroll
        for (int bj = 0; bj < 2; ++bj)
#pragma unroll
            for (int n = 0; n < 2; ++n) bv[bj][n] = (mode == 2) ? *(const f32x4*)(gate_b + (pn - 16) * 256 + bj * 128 + cl + 4 * n) : (f32x4){0.f, 0.f, 0.f, 0.f};
#pragma unroll
        for (int ai = 0; ai < 2; ++ai)
#pragma unroll
            for (int m = 0; m < 4; ++m) {
                u16* rowp = base + (size_t)(row0 + ai * 128 + m * 16) * ld + cl;
#pragma unroll
                for (int bj = 0; bj < 2; ++bj) {
                    f32x4 v0 = acc[ai][bj][m][0], v1 = acc[ai][bj][m][1];
                    if (mode == 1) {
#pragma unroll
                        for (int j = 0; j < 4; ++j) { v0[j] = gelu_tanh(v0[j]); v1[j] = gelu_tanh(v1[j]); }
                    } else if (mode == 2) {
#pragma unroll
                        for (int j = 0; j < 4; ++j) { v0[j] = sigmoidf_(v0[j] + bv[bj][0][j]); v1[j] = sigmoidf_(v1[j] + bv[bj][1][j]); }
                    }
                    u32x4 w; w.x = pk2(v0[0], v0[1]); w.y = pk2(v0[2], v0[3]); w.z = pk2(v1[0], v1[1]); w.w = pk2(v1[2], v1[3]);
                    *(u32x4*)(rowp + bj * 128) = w;
                }
            }
    }
};
struct EpiGate {
    static constexpr bool PERM = true, AFTER_DRAIN = false, TWOSEG = false;
    u16* O; const u16* gsrc; const u16* addsrc;
    __device__ __forceinline__ void operator()(const f32x4 (&acc)[2][2][4][2], const pg8::Unit& u, int wr, int wc, int fr, int fq) const {
        const int row0 = u.pm * 256 + wr * 64 + fr, col0 = u.pn * 256 + wc * 32 + 8 * fq;
#pragma unroll
        for (int ai = 0; ai < 2; ++ai)
#pragma unroll
            for (int m = 0; m < 4; ++m) {
                const size_t row = (size_t)(row0 + ai * 128 + m * 16);
#pragma unroll
                for (int bj = 0; bj < 2; ++bj) {
                    const int col = col0 + bj * 128;
                    const u32x4 gw = *(const u32x4*)(gsrc + row * 2048 + col);
                    u32x4 aw = {0u, 0u, 0u, 0u};
                    if (addsrc) aw = *(const u32x4*)(addsrc + row * 1024 + col);
                    const f32x4 v0 = acc[ai][bj][m][0], v1 = acc[ai][bj][m][1];
                    u32x4 w;
                    w.x = pk2(bflo(aw.x) + bflo(gw.x) * v0[0], bfhi(aw.x) + bfhi(gw.x) * v0[1]);
                    w.y = pk2(bflo(aw.y) + bflo(gw.y) * v0[2], bfhi(aw.y) + bfhi(gw.y) * v0[3]);
                    w.z = pk2(bflo(aw.z) + bflo(gw.z) * v1[0], bfhi(aw.z) + bfhi(gw.z) * v1[1]);
                    w.w = pk2(bflo(aw.w) + bflo(gw.w) * v1[2], bfhi(aw.w) + bfhi(gw.w) * v1[3]);
                    *(u32x4*)(O + row * 1024 + col) = w;
                }
            }
    }
};
struct EpiGate2 {
    static constexpr bool PERM = true, AFTER_DRAIN = false, TWOSEG = true;
    u16* O; const u16* gb;
    __device__ __forceinline__ void mid(f32x4 (&acc)[2][2][4][2], const pg8::Unit& u, int wr, int wc, int fr, int fq) const {
        const int row0 = u.pm * 256 + wr * 64 + fr, col0 = u.pn * 256 + wc * 32 + 8 * fq;
#pragma unroll
        for (int ai = 0; ai < 2; ++ai)
#pragma unroll
            for (int m = 0; m < 4; ++m) {
                const size_t row = (size_t)(row0 + ai * 128 + m * 16);
#pragma unroll
                for (int bj = 0; bj < 2; ++bj) {
                    const int col = col0 + bj * 128;
                    const u32x4 g0 = *(const u32x4*)(gb + row * 2048 + col), g1 = *(const u32x4*)(gb + row * 2048 + 1024 + col);
                    f32x4& v0 = acc[ai][bj][m][0]; f32x4& v1 = acc[ai][bj][m][1];
                    v0[0] *= bflo(g0.x) * __builtin_amdgcn_rcpf(bflo(g1.x)); v0[1] *= bfhi(g0.x) * __builtin_amdgcn_rcpf(bfhi(g1.x)); v0[2] *= bflo(g0.y) * __builtin_amdgcn_rcpf(bflo(g1.y)); v0[3] *= bfhi(g0.y) * __builtin_amdgcn_rcpf(bfhi(g1.y));
                    v1[0] *= bflo(g0.z) * __builtin_amdgcn_rcpf(bflo(g1.z)); v1[1] *= bfhi(g0.z) * __builtin_amdgcn_rcpf(bfhi(g1.z)); v1[2] *= bflo(g0.w) * __builtin_amdgcn_rcpf(bflo(g1.w)); v1[3] *= bfhi(g0.w) * __builtin_amdgcn_rcpf(bfhi(g1.w));
                }
            }
    }
    __device__ __forceinline__ void operator()(const f32x4 (&acc)[2][2][4][2], const pg8::Unit& u, int wr, int wc, int fr, int fq) const {
        const int row0 = u.pm * 256 + wr * 64 + fr, col0 = u.pn * 256 + wc * 32 + 8 * fq;
#pragma unroll
        for (int ai = 0; ai < 2; ++ai)
#pragma unroll
            for (int m = 0; m < 4; ++m) {
                const size_t row = (size_t)(row0 + ai * 128 + m * 16);
#pragma unroll
                for (int bj = 0; bj < 2; ++bj) {
                    const int col = col0 + bj * 128;
                    const u32x4 g1 = *(const u32x4*)(gb + row * 2048 + 1024 + col);
                    const f32x4 v0 = acc[ai][bj][m][0], v1 = acc[ai][bj][m][1];
                    u32x4 w;
                    w.x = pk2(bflo(g1.x) * v0[0], bfhi(g1.x) * v0[1]); w.y = pk2(bflo(g1.y) * v0[2], bfhi(g1.y) * v0[3]);
                    w.z = pk2(bflo(g1.z) * v1[0], bfhi(g1.z) * v1[1]); w.w = pk2(bflo(g1.w) * v1[2], bfhi(g1.w) * v1[3]);
                    *(u32x4*)(O + row * 1024 + col) = w;
                }
            }
    }
};
struct EpiRes1 {
    static constexpr bool PERM = true, AFTER_DRAIN = false, TWOSEG = false;
    const float* x; float* out; u16* xw; const float* n2w; float* rowss;
    __device__ __forceinline__ void operator()(const f32x4 (&acc)[2][2][4][2], const pg8::Unit& u, int wr, int wc, int fr, int fq) const {
        const int row0 = u.pm * 256 + wr * 64 + fr, col0 = u.pn * 256 + wc * 32 + 8 * fq;
        f32x4 nw[2][2];
#pragma unroll
        for (int bj = 0; bj < 2; ++bj)
#pragma unroll
            for (int n = 0; n < 2; ++n) nw[bj][n] = *(const f32x4*)(n2w + col0 + bj * 128 + 4 * n);
#pragma unroll
        for (int ai = 0; ai < 2; ++ai)
#pragma unroll
            for (int m = 0; m < 4; ++m) {
                const size_t row = (size_t)(row0 + ai * 128 + m * 16);
                float ss = 0.f;
#pragma unroll
                for (int bj = 0; bj < 2; ++bj) {
                    const int col = col0 + bj * 128;
                    const float* xp = x + row * 1024 + col;
                    f32x4 v0 = *(const f32x4*)xp + acc[ai][bj][m][0], v1 = *(const f32x4*)(xp + 4) + acc[ai][bj][m][1];
                    float* op = out + row * 1024 + col;
                    *(f32x4*)op = v0; *(f32x4*)(op + 4) = v1;
#pragma unroll
                    for (int j = 0; j < 4; ++j) ss += v0[j] * v0[j] + v1[j] * v1[j];
                    v0 = v0 * nw[bj][0]; v1 = v1 * nw[bj][1];
                    u32x4 w; w.x = pk2(v0[0], v0[1]); w.y = pk2(v0[2], v0[3]); w.z = pk2(v1[0], v1[1]); w.w = pk2(v1[2], v1[3]);
                    *(u32x4*)(xw + row * 1024 + col) = w;
                }
                ss += __shfl_xor(ss, 16); ss += __shfl_xor(ss, 32);
                if (fq == 0) atomicAdd(rowss + row, ss);
            }
    }
};
struct EpiFF1 {
    static constexpr bool PERM = true, AFTER_DRAIN = false, TWOSEG = false;
    u16* hid; const float* rowss;
    __device__ __forceinline__ void operator()(const f32x4 (&acc)[2][2][4][2], const pg8::Unit& u, int wr, int wc, int fr, int fq) const {
        const int row0 = u.pm * 256 + wr * 64 + fr, col0 = u.pn * 256 + wc * 32 + 8 * fq;
#pragma unroll
        for (int ai = 0; ai < 2; ++ai)
#pragma unroll
            for (int m = 0; m < 4; ++m) {
                const size_t row = (size_t)(row0 + ai * 128 + m * 16);
                const float rs = rsqrtf(rowss[row] * (1.0f / 1024.0f) + EPSV);
#pragma unroll
                for (int bj = 0; bj < 2; ++bj) {
                    f32x4 v0 = acc[ai][bj][m][0] * rs, v1 = acc[ai][bj][m][1] * rs;
#pragma unroll
                    for (int j = 0; j < 4; ++j) { const float a = fmaxf(v0[j], 0.f), b = fmaxf(v1[j], 0.f); v0[j] = a * a; v1[j] = b * b; }
                    u32x4 w; w.x = pk2(v0[0], v0[1]); w.y = pk2(v0[2], v0[3]); w.z = pk2(v1[0], v1[1]); w.w = pk2(v1[2], v1[3]);
                    *(u32x4*)(hid + row * DFF + col0 + bj * 128) = w;
                }
            }
    }
};
struct EpiRes2 {
    static constexpr bool PERM = true, AFTER_DRAIN = false, TWOSEG = false;
    float* out;
    __device__ __forceinline__ void operator()(const f32x4 (&acc)[2][2][4][2], const pg8::Unit& u, int wr, int wc, int fr, int fq) const {
        const int row0 = u.pm * 256 + wr * 64 + fr, col0 = u.pn * 256 + wc * 32 + 8 * fq;
#pragma unroll
        for (int ai = 0; ai < 2; ++ai)
#pragma unroll
            for (int m = 0; m < 4; ++m) {
                const size_t row = (size_t)(row0 + ai * 128 + m * 16);
#pragma unroll
                for (int bj = 0; bj < 2; ++bj) {
                    float* op = out + row * 1024 + col0 + bj * 128;
                    *(f32x4*)op = *(const f32x4*)op + acc[ai][bj][m][0];
                    *(f32x4*)(op + 4) = *(const f32x4*)(op + 4) + acc[ai][bj][m][1];
                }
            }
    }
};
template <class Epi>
__device__ __forceinline__ void run_gemm(LAS unsigned char* L, const u16* A, const u16* Bt, int N, int K, const Epi& E, int reps = 1) {
    pg8::Gemm g; g.A = A; g.Bt = Bt; g.M = M; g.N = N; g.K = K; g.A2 = A; g.Bt2 = Bt;
    pg8::StaticOrder S; S.init(M, N, (int)gridDim.x, (int)blockIdx.x); S.reps = reps;
    pg8::gemm_phase<Epi, pg8::StaticOrder, false>(L, g, S, E, nullptr);
}

template <class Epi>
__device__ __forceinline__ void run_gemm2(LAS unsigned char* L, const u16* A, const u16* Bt, const u16* A2, const u16* Bt2, int N, int K, const Epi& E) {
    pg8::Gemm g; g.A = A; g.Bt = Bt; g.M = M; g.N = N; g.K = K; g.A2 = A2; g.Bt2 = Bt2;
    pg8::StaticOrder S; S.init(M, N, (int)gridDim.x, (int)blockIdx.x); S.segs = 2;
    pg8::gemm_phase<Epi, pg8::StaticOrder, false>(L, g, S, E, nullptr);
}

__device__ void norm_phase(const Params& p) {
    const int tid = threadIdx.x, lane = tid & 63, gw = blockIdx.x * 8 + (tid >> 6), GW = gridDim.x * 8;
    unsigned char* ws = p.ws;
    u16* qb = (u16*)(ws + WS_QB); u16* kb = (u16*)(ws + WS_KB); const u16* vb = (const u16*)(ws + WS_VB); u16* vT = (u16*)(ws + WS_VT);
    const float* ikw = (const float*)(ws + WS_IKW); u16* ikn = (u16*)(ws + WS_IKN);
    const float* qnw = p.in[I_QNW] + (lane & 3) * 16; const float* knw = p.in[I_KNW] + (lane & 15) * 4; const float iknw = p.in[I_IKNW][lane];
    f32x4 qw4[4]; for (int i = 0; i < 4; ++i) qw4[i] = *(const f32x4*)(qnw + 4 * i);
    const f32x4 kw4 = *(const f32x4*)knw;
    for (int row0 = gw; row0 < M; row0 += 2 * GW) {
        u32x4 qw0[2], qw1[2]; u32x2 kw[2]; float iv[2];
#pragma unroll
        for (int z = 0; z < 2; ++z) {
            const size_t row = (size_t)(row0 + z * GW);
            const u16* qr = qb + row * 1024 + 16 * lane;
            qw0[z] = *(const u32x4*)qr; qw1[z] = *(const u32x4*)(qr + 8);
            kw[z] = *(const u32x2*)(kb + row * 256 + 4 * lane);
            iv[z] = ikw[row * 72 + lane];
        }
#pragma unroll
        for (int z = 0; z < 2; ++z) {
            const size_t row = (size_t)(row0 + z * GW);
            {
                u32x4 w0 = qw0[z], w1 = qw1[z];
                float v[16];
                v[0] = bflo(w0.x); v[1] = bfhi(w0.x); v[2] = bflo(w0.y); v[3] = bfhi(w0.y); v[4] = bflo(w0.z); v[5] = bfhi(w0.z); v[6] = bflo(w0.w); v[7] = bfhi(w0.w);
                v[8] = bflo(w1.x); v[9] = bfhi(w1.x); v[10] = bflo(w1.y); v[11] = bfhi(w1.y); v[12] = bflo(w1.z); v[13] = bfhi(w1.z); v[14] = bflo(w1.w); v[15] = bfhi(w1.w);
                float ss = 0.f;
#pragma unroll
                for (int j = 0; j < 16; ++j) ss += v[j] * v[j];
                ss += __shfl_xor(ss, 1); ss += __shfl_xor(ss, 2);
                const float rs = rsqrtf(ss * (1.0f / 64.0f) + EPSV) * 0.18033688011f;
#pragma unroll
                for (int j = 0; j < 16; ++j) v[j] = v[j] * rs * qw4[j >> 2][j & 3];
                w0.x = pk2(v[0], v[1]); w0.y = pk2(v[2], v[3]); w0.z = pk2(v[4], v[5]); w0.w = pk2(v[6], v[7]);
                w1.x = pk2(v[8], v[9]); w1.y = pk2(v[10], v[11]); w1.z = pk2(v[12], v[13]); w1.w = pk2(v[14], v[15]);
                u16* qr = qb + row * 1024 + 16 * lane;
                *(u32x4*)qr = w0; *(u32x4*)(qr + 8) = w1;
            }
            {
                u32x2 w = kw[z];
                const float v0 = bflo(w.x), v1 = bfhi(w.x), v2 = bflo(w.y), v3 = bfhi(w.y);
                float ss = v0 * v0 + v1 * v1 + v2 * v2 + v3 * v3;
                ss += __shfl_xor(ss, 1); ss += __shfl_xor(ss, 2); ss += __shfl_xor(ss, 4); ss += __shfl_xor(ss, 8);
                const float rs = rsqrtf(ss * (1.0f / 64.0f) + EPSV);
                w.x = pk2(v0 * rs * kw4[0], v1 * rs * kw4[1]); w.y = pk2(v2 * rs * kw4[2], v3 * rs * kw4[3]);
                *(u32x2*)(kb + row * 256 + 4 * lane) = w;
            }
            {
                const float ss = wave_sum(iv[z] * iv[z]);
                ikn[row * 64 + lane] = f2bf(iv[z] * rsqrtf(ss * (1.0f / 64.0f) + EPSV) * iknw);
            }
        }
    }
    for (int it = gw; it < NB * 4 * (T / 8); it += GW) {
        const int tg = it & 511, g = (it >> 9) & 3, b = it >> 11, t0 = tg * 8;
        const u16* src = vb + (size_t)(b * T + t0) * 256 + g * 64 + lane;
        u16 v[8];
#pragma unroll
        for (int j = 0; j < 8; ++j) v[j] = src[j * 256];
        u32x4 w; w.x = v[0] | ((unsigned)v[1] << 16); w.y = v[2] | ((unsigned)v[3] << 16); w.z = v[4] | ((unsigned)v[5] << 16); w.w = v[6] | ((unsigned)v[7] << 16);
        *(u32x4*)(vT + ((size_t)((b * 4 + g) * 64 + lane)) * T + t0) = w;
    }
}

template <int MODE>
__device__ void rnn_phase(const Params& p, LAS unsigned char* L, int reps) {
    const int tid = threadIdx.x, hb = tid >> 8, t2 = tid & 255, lane = tid & 63, wv = t2 >> 6, fr = lane & 15, fq = lane >> 4;
    const int ch = t2 & 63, qt = t2 >> 6;
    LAS unsigned char* Lh = L + hb * 55296;
    LAS float* xs = (LAS float*)Lh;
    LAS float* as = (LAS float*)Lh;
    LAS float* xcs = (LAS float*)(Lh + 17408);
    LAS float* us = (LAS float*)(Lh + 34816);
    LAS float* part = (LAS float*)(Lh + 52224);
    LAS float* cin = (LAS float*)(Lh + 54272);
    unsigned char* ws = p.ws;
    const u16* rx = (const u16*)(ws + WS_RX); u16* gt = (u16*)(ws + WS_GT);
    float* PEND = (float*)(ws + WS_PEND); float* HEND = (float*)(ws + WS_HEND);
    const u16* wgT = (const u16*)(ws + WS_WT_GATE); const float* spl = (const float*)(ws + WS_SPL);
    for (int it = blockIdx.x; it < 256 * reps; it += gridDim.x) {
        const int item = (it & 255) * 2 + hb, b = item >> 6, n = (item >> 2) & 15, seg = item & 3, gch = n * 64 + ch;
        const float cw0 = p.in[I_CONVW][gch], cw1 = p.in[I_CONVW][1024 + gch], cw2 = p.in[I_CONVW][2048 + gch], cw3 = p.in[I_CONVW][3072 + gch], cb = p.in[I_CONVB][gch];
        bf16x8 waf[4][2], wxf[4][2];
#pragma unroll
        for (int m = 0; m < 4; ++m)
#pragma unroll
            for (int ks = 0; ks < 2; ++ks) {
                const size_t o = (size_t)((n * 64 + 16 * m + fr) * 64 + 32 * ks + 8 * fq);
                waf[m][ks] = *(const bf16x8*)(wgT + o); wxf[m][ks] = *(const bf16x8*)(wgT + 65536 + o);
            }
        if (MODE == 1 && qt == 0) {
            float h = 0.f;
            for (int c0 = 0; c0 < seg * 16; c0 += 16) {
                float pe[16], he[16];
#pragma unroll
                for (int j = 0; j < 16; ++j) { const size_t o = (size_t)((b * 64 + c0 + j) * 1024 + gch); pe[j] = PEND[o]; he[j] = HEND[o]; }
#pragma unroll
                for (int j = 0; j < 16; ++j) h = pe[j] * h + he[j];
            }
            cin[ch] = h;
        }
        u32x4 xpre[3];
#pragma unroll
        for (int i = 0; i < 3; ++i) {
            const int rr = (t2 >> 3) + 32 * i, cg8 = t2 & 7, tt = seg * 1024 - 3 + rr;
            xpre[i] = (u32x4){0u, 0u, 0u, 0u};
            if (rr < 67 && tt >= 0) xpre[i] = *(const u32x4*)(rx + (size_t)(b * T + tt) * 1024 + n * 64 + cg8 * 8);
        }
        for (int cc = 0; cc < 16; ++cc) {
            const int c = seg * 16 + cc, t0 = c * 64;
#pragma unroll
            for (int i = 0; i < 3; ++i) {
                const int rr = (t2 >> 3) + 32 * i, cg8 = t2 & 7;
                if (rr < 67) {
                    const u32x4 w = xpre[i];
                    f32x4 lo = {bflo(w.x), bfhi(w.x), bflo(w.y), bfhi(w.y)}, hi = {bflo(w.z), bfhi(w.z), bflo(w.w), bfhi(w.w)};
                    *(LAS f32x4*)(xs + rr * 64 + cg8 * 8) = lo; *(LAS f32x4*)(xs + rr * 64 + cg8 * 8 + 4) = hi;
                }
            }
            if (cc < 15) {
#pragma unroll
                for (int i = 0; i < 3; ++i) {
                    const int rr = (t2 >> 3) + 32 * i, cg8 = t2 & 7, tt = t0 + 64 - 3 + rr;
                    if (rr < 67) xpre[i] = *(const u32x4*)(rx + (size_t)(b * T + tt) * 1024 + n * 64 + cg8 * 8);
                }
            }
            __syncthreads();
            {
                float x0 = xs[(16 * qt) * 64 + ch], x1 = xs[(16 * qt + 1) * 64 + ch], x2 = xs[(16 * qt + 2) * 64 + ch];
#pragma unroll
                for (int j = 0; j < 16; ++j) {
                    const int tt = 16 * qt + j;
                    const float x3 = xs[(tt + 3) * 64 + ch];
                    xcs[tt * 68 + ch] = cb + cw0 * x0 + cw1 * x1 + cw2 * x2 + cw3 * x3;
                    x0 = x1; x1 = x2; x2 = x3;
                }
            }
            __syncthreads();
            {
                const int trow = 16 * wv + fr;
                bf16x8 yf[2];
#pragma unroll
                for (int ks = 0; ks < 2; ++ks) {
                    const f32x4 a = *(const LAS f32x4*)(xcs + trow * 68 + 32 * ks + 8 * fq), bq = *(const LAS f32x4*)(xcs + trow * 68 + 32 * ks + 8 * fq + 4);
                    u32x4 w; w.x = pk2(a[0], a[1]); w.y = pk2(a[2], a[3]); w.z = pk2(bq[0], bq[1]); w.w = pk2(bq[2], bq[3]);
                    yf[ks] = as_bf16x8(w);
                }
#pragma unroll
                for (int m = 0; m < 4; ++m) {
                    f32x4 ga = {0.f, 0.f, 0.f, 0.f}, gx = {0.f, 0.f, 0.f, 0.f};
#pragma unroll
                    for (int ks = 0; ks < 2; ++ks) { ga = __builtin_amdgcn_mfma_f32_16x16x32_bf16(waf[m][ks], yf[ks], ga, 0, 0, 0); gx = __builtin_amdgcn_mfma_f32_16x16x32_bf16(wxf[m][ks], yf[ks], gx, 0, 0, 0); }
                    const int e0 = 16 * m + 4 * fq;
                    const f32x4 ba4 = *(const f32x4*)(p.in[I_BA] + n * 64 + e0), bx4 = *(const f32x4*)(p.in[I_BX] + n * 64 + e0), sp4 = *(const f32x4*)(spl + n * 64 + e0);
                    const f32x4 xc4 = *(const LAS f32x4*)(xcs + trow * 68 + e0);
                    f32x4 a4, u4;
#pragma unroll
                    for (int r = 0; r < 4; ++r) {
                        const float ra = sigmoidf_(ga[r] + ba4[r]), ri = sigmoidf_(gx[r] + bx4[r]);
                        const float la = ra * sp4[r];
                        const float a = __expf(la), z = 2.0f * la;
                        const float om = (z > -0.03f) ? -z * (1.0f + z * (0.5f + z * (0.16666667f + z * 0.041666667f))) : 1.0f - a * a;
                        a4[r] = a;
                        u4[r] = __builtin_amdgcn_sqrtf(om) * (ri * xc4[r]);
                    }
                    *(LAS f32x4*)(as + trow * 68 + e0) = a4; *(LAS f32x4*)(us + trow * 68 + e0) = u4;
                }
            }
            __syncthreads();
            u16 gpre[16];
            if (MODE == 1) {
                const u16* gp = gt + (size_t)(b * T + t0 + 16 * qt) * 1024 + gch;
#pragma unroll
                for (int j = 0; j < 16; ++j) gpre[j] = gp[(size_t)j * 1024];
            }
            {
                float P = 1.f, H = 0.f;
#pragma unroll
                for (int j = 0; j < 16; ++j) { const int tt = 16 * qt + j; const float a = as[tt * 68 + ch]; H = a * H + us[tt * 68 + ch]; P *= a; }
                part[(qt * 64 + ch) * 2] = P; part[(qt * 64 + ch) * 2 + 1] = H;
            }
            __syncthreads();
            if (MODE == 0) {
                if (qt == 0) {
                    float Pt = 1.f, Ht = 0.f;
#pragma unroll
                    for (int q = 0; q < 4; ++q) { const float Pq = part[(q * 64 + ch) * 2], Hq = part[(q * 64 + ch) * 2 + 1]; Ht = Pq * Ht + Hq; Pt *= Pq; }
                    const size_t o = (size_t)((b * 64 + c) * 1024 + gch);
                    PEND[o] = Pt; HEND[o] = Ht;
                }
            } else {
                float h = cin[(c & 1) * 64 + ch], hs = 0.f;
#pragma unroll
                for (int q = 0; q < 4; ++q) { if (q == qt) hs = h; const float Pq = part[(q * 64 + ch) * 2], Hq = part[(q * 64 + ch) * 2 + 1]; h = Pq * h + Hq; }
                if (qt == 0) cin[((c + 1) & 1) * 64 + ch] = h;
                h = hs;
                u16* gp = gt + (size_t)(b * T + t0 + 16 * qt) * 1024 + gch;
#pragma unroll
                for (int j = 0; j < 16; ++j) {
                    const int tt = 16 * qt + j;
                    h = as[tt * 68 + ch] * h + us[tt * 68 + ch];
                    gp[(size_t)j * 1024] = f2bf(h * bf2f(gpre[j]));
                }
            }
            __syncthreads();
        }
    }
}

__device__ __forceinline__ unsigned wave_suffix_sum(unsigned x, int lane) {
    unsigned v = x;
    v += (unsigned)__builtin_amdgcn_update_dpp(0, (int)v, 0x101, 0xf, 0xf, false);
    v += (unsigned)__builtin_amdgcn_update_dpp(0, (int)v, 0x102, 0xf, 0xf, false);
    v += (unsigned)__builtin_amdgcn_update_dpp(0, (int)v, 0x104, 0xf, 0xf, false);
    v += (unsigned)__builtin_amdgcn_update_dpp(0, (int)v, 0x108, 0xf, 0xf, false);
    const unsigned t1 = (unsigned)__builtin_amdgcn_readlane((int)v, 16), t2 = (unsigned)__builtin_amdgcn_readlane((int)v, 32), t3 = (unsigned)__builtin_amdgcn_readlane((int)v, 48);
    const int row = lane >> 4;
    return v + ((row == 0) ? (t1 + t2 + t3) : (row == 1) ? (t2 + t3) : (row == 2) ? t3 : 0u);
}
__device__ __forceinline__ void hist_find(LAS unsigned* hist, int lane, unsigned target, unsigned& bin, unsigned& above, unsigned& nbin) {
    asm volatile("s_waitcnt lgkmcnt(0)" ::: "memory");
    unsigned s = 0;
#pragma unroll
    for (int i = 0; i < 8; ++i) { const u32x4 a = *(const LAS u32x4*)(hist + 32 * lane + 4 * i); s += a.x + a.y + a.z + a.w; }
    const unsigned inc = wave_suffix_sum(s, lane);
    const u64 bal = __ballot(inc >= target);
    const int ls = 63 - __builtin_clzll(bal);
    const unsigned incn = (unsigned)__builtin_amdgcn_readlane((int)inc, (ls + 1) & 63);
    const unsigned ab = (ls == 63) ? 0u : incn;
    const unsigned t = (lane < 32) ? hist[32 * ls + lane] : 0u;
    const unsigned inc2 = wave_suffix_sum(t, lane);
    const u64 bal2 = __ballot(lane < 32 && ab + inc2 >= target);
    const int is = 63 - __builtin_clzll(bal2);
    const unsigned inc2n = (unsigned)__builtin_amdgcn_readlane((int)inc2, (is + 1) & 63);
    above = ab + ((is == 31) ? 0u : inc2n);
    bin = (unsigned)(32 * ls + is);
    nbin = (unsigned)__builtin_amdgcn_readlane((int)t, is);
    asm volatile("" ::: "memory");
#pragma unroll
    for (int i = 0; i < 8; ++i) *(LAS u32x4*)(hist + 256 * i + 4 * lane) = (u32x4){0u, 0u, 0u, 0u};
    asm volatile("s_waitcnt lgkmcnt(0)" ::: "memory");
}
#define HIST_ADD(ptr) (void)__hip_atomic_fetch_add((ptr), 1u, __ATOMIC_RELAXED, __HIP_MEMORY_SCOPE_WAVEFRONT)

struct IdxQ { u32x4 a, b; float w; };
__device__ __forceinline__ int idx_unit_tok0(int u) { const int c = 63 - (u >> 5), b = (u >> 2) & 7, qg = u & 3; return b * T + 64 * c + 16 * qg; }
__device__ __forceinline__ IdxQ idx_fetch(const u16* iq, const float* ikw, int tok0, int tid) {
    IdxQ r; const int row = tid >> 5, ch = tid & 31;
    const u16* src = iq + (size_t)(tok0 + row) * 512;
    r.a = *(const u32x4*)(src + ch * 8); r.b = *(const u32x4*)(src + 256 + ch * 8);
    r.w = (tid < 128) ? ikw[(size_t)(tok0 + (tid >> 3)) * 72 + 64 + (tid & 7)] : 0.f;
    return r;
}
__device__ __forceinline__ void idx_park(LAS unsigned char* L, const IdxQ& r, int tid) {
    const int row = tid >> 5, ch = tid & 31;
    *(LAS u32x4*)(L + 65536 + row * 1040 + ch * 16) = r.a; *(LAS u32x4*)(L + 65536 + row * 1040 + 512 + ch * 16) = r.b;
    if (tid < 128) *(LAS float*)(L + 65536 + 16640 + tid * 4) = r.w;
}
__device__ void indexer_phase(const Params& p, LAS unsigned char* L, int reps) {
    const int tid = threadIdx.x, wid = tid >> 6, lane = tid & 63, fr = lane & 15, fq = lane >> 4, G = gridDim.x;
    unsigned char* ws = p.ws;
    float* slab = (float*)(ws + WS_SLAB) + (size_t)blockIdx.x * 16 * 4096;
    const u16* iq = (const u16*)(ws + WS_IQ); const u16* ikn = (const u16*)(ws + WS_IKN); const float* ikw = (const float*)(ws + WS_IKW);
    u64* maskT = (u64*)(ws + WS_MASK);
    const float idx_scale = 0.04419417382f;
    LAS unsigned* hist = (LAS unsigned*)(L + wid * 8192);
#pragma unroll
    for (int i = 0; i < 8; ++i) *(LAS u32x4*)(hist + 256 * i + 4 * lane) = (u32x4){0u, 0u, 0u, 0u};
    {
        const int u0 = (int)blockIdx.x;
        if (u0 < 1920 * reps) { const IdxQ r0 = idx_fetch(iq, ikw, idx_unit_tok0(u0 >= 1920 ? u0 - 1920 : u0), tid); idx_park(L, r0, tid); }
        __syncthreads();
    }
    for (int k = 0; k * G < 1920 * reps; ++k) {
        int u = k * G + ((k & 1) ? (G - 1 - (int)blockIdx.x) : (int)blockIdx.x);
        if (u >= 1920 * reps) continue;
        if (u >= 1920) u -= 1920;
        const int c = 63 - (u >> 5), b = (u >> 2) & 7, qg = u & 3;
        int un = (k + 1) * G + (((k + 1) & 1) ? (G - 1 - (int)blockIdx.x) : (int)blockIdx.x);
        const bool has_next = un < 1920 * reps;
        if (un >= 1920) un -= 1920;
        bf16x8 yq[8][2]; float wq[8];
#pragma unroll
        for (int h = 0; h < 8; ++h) {
#pragma unroll
            for (int ks = 0; ks < 2; ++ks) yq[h][ks] = *(const LAS bf16x8*)(L + 65536 + fr * 1040 + (h * 64 + 32 * ks + 8 * fq) * 2);
            wq[h] = *(const LAS float*)(L + 65536 + 16640 + (fr * 8 + h) * 4);
        }
        const int ntile = 4 * (c + 1);
#pragma unroll 1
        for (int rpA = 0; rpA < 1 + ((p.dbl >> 12) & 1); ++rpA) {
            const u16* kbase = ikn + (size_t)(b * T + fr) * 64 + 8 * fq;
            int tile = wid;
            bool two = (tile + 8) < ntile;
            bf16x8 x00, x01, x10, x11;
            if (tile < ntile) {
                const u16* kp0 = kbase + (size_t)tile * 1024; const u16* kp1 = kp0 + (two ? 8192 : 0);
                x00 = *(const bf16x8*)kp0; x01 = *(const bf16x8*)(kp0 + 32); x10 = *(const bf16x8*)kp1; x11 = *(const bf16x8*)(kp1 + 32);
            }
            while (tile < ntile) {
                const int ntl = tile + 16; const bool ntwo = (ntl + 8) < ntile;
                bf16x8 y00, y01, y10, y11;
                {
                    const int nt0 = (ntl < ntile) ? ntl : tile;
                    const u16* kp0 = kbase + (size_t)nt0 * 1024; const u16* kp1 = kp0 + (ntwo ? 8192 : 0);
                    y00 = *(const bf16x8*)kp0; y01 = *(const bf16x8*)(kp0 + 32); y10 = *(const bf16x8*)kp1; y11 = *(const bf16x8*)(kp1 + 32);
                }
                f32x4 s0 = {0.f, 0.f, 0.f, 0.f}, s1 = {0.f, 0.f, 0.f, 0.f};
#pragma unroll
                for (int h = 0; h < 8; ++h) {
                    f32x4 a0 = {0.f, 0.f, 0.f, 0.f}, a1 = {0.f, 0.f, 0.f, 0.f};
                    a0 = __builtin_amdgcn_mfma_f32_16x16x32_bf16(x00, yq[h][0], a0, 0, 0, 0); a0 = __builtin_amdgcn_mfma_f32_16x16x32_bf16(x01, yq[h][1], a0, 0, 0, 0);
                    a1 = __builtin_amdgcn_mfma_f32_16x16x32_bf16(x10, yq[h][0], a1, 0, 0, 0); a1 = __builtin_amdgcn_mfma_f32_16x16x32_bf16(x11, yq[h][1], a1, 0, 0, 0);
#pragma unroll
                    for (int r = 0; r < 4; ++r) { s0[r] += wq[h] * fmaxf(a0[r], 0.f); s1[r] += wq[h] * fmaxf(a1[r], 0.f); }
                }
                *(f32x4*)(slab + fr * 4096 + 16 * tile + 4 * fq) = s0 * idx_scale;
                if (two) *(f32x4*)(slab + fr * 4096 + 16 * (tile + 8) + 4 * fq) = s1 * idx_scale;
                x00 = y00; x01 = y01; x10 = y10; x11 = y11; tile = ntl; two = ntwo;
            }
        }
        __syncthreads();
        IdxQ rn; if (has_next) rn = idx_fetch(iq, ikw, idx_unit_tok0(un), tid);
        const int R = c + 1;
#pragma unroll 1
        for (int qi = 0; qi < 2 * (1 + ((p.dbl >> 13) & 1)); ++qi) {
            const int q = 2 * wid + (qi & 1);
            const float* row = slab + q * 4096 + lane;
            unsigned key[64];
            {
                float raw[64];
#pragma unroll
                for (int gI = 0; gI < 4; ++gI) {
                    if (R > 16 * gI) {
#pragma unroll
                        for (int r = 16 * gI; r < 16 * gI + 16; ++r) raw[r] = row[64 * r];
                    } else {
#pragma unroll
                        for (int r = 16 * gI; r < 16 * gI + 16; ++r) raw[r] = 0.f;
                    }
                }
#pragma unroll
                for (int r = 0; r < 64; ++r) {
                    const unsigned bts = __float_as_uint(raw[r] + 0.0f);
                    key[r] = (r < R) ? ((bts & 0x80000000u) ? ~bts : (bts | 0x80000000u)) : 0u;
                }
            }
            unsigned b1, ab1, n1, b2, ab2, n2, b3, ab3, n3;
#pragma unroll
            for (int gI = 0; gI < 4; ++gI)
                if (R > 16 * gI) {
#pragma unroll
                    for (int r = 16 * gI; r < 16 * gI + 16; ++r) if (r < R) HIST_ADD(hist + (key[r] >> 21));
                }
            hist_find(hist, lane, 256u, b1, ab1, n1);
#pragma unroll
            for (int gI = 0; gI < 4; ++gI)
                if (R > 16 * gI) {
#pragma unroll
                    for (int r = 16 * gI; r < 16 * gI + 16; ++r) if ((key[r] >> 21) == b1) HIST_ADD(hist + ((key[r] >> 10) & 2047u));
                }
            hist_find(hist, lane, 256u - ab1, b2, ab2, n2);
            const unsigned pre22 = (b1 << 11) | b2;
            unsigned thr; int need;
            if (256u - ab1 - ab2 == n2) {
                thr = pre22 << 10; need = 1 << 30; b3 = 0u; ab3 = 0u; n3 = 0u;
            } else {
#pragma unroll
                for (int gI = 0; gI < 4; ++gI)
                    if (R > 16 * gI) {
#pragma unroll
                        for (int r = 16 * gI; r < 16 * gI + 16; ++r) if ((key[r] >> 10) == pre22) HIST_ADD(hist + (key[r] & 1023u));
                    }
                hist_find(hist, lane, 256u - ab1 - ab2, b3, ab3, n3);
                thr = (pre22 << 10) | b3;
                need = 256 - (int)(ab1 + ab2 + ab3);
                if (need == (int)n3) need = 1 << 30;
            }
            u64 myword = 0ull;
            if (need >= (1 << 29)) {
#pragma unroll
                for (int gI = 0; gI < 4; ++gI)
                    if (R > 16 * gI) {
#pragma unroll
                        for (int r = 16 * gI; r < 16 * gI + 16; ++r) { const u64 sel = __ballot(key[r] >= thr); if (lane == r) myword = sel; }
                    }
            } else {
                const u64 lt = (1ull << lane) - 1ull;
#pragma unroll
                for (int r = 0; r < 64; ++r) {
                    const bool iseq = key[r] == thr;
                    const u64 eq = __ballot(iseq);
                    const int pre = __popcll(eq & lt);
                    const u64 sel = __ballot(key[r] > thr || (iseq && pre < need));
                    need -= __popcll(eq);
                    if (lane == r) myword = sel;
                }
            }
            if (lane < R) maskT[(((size_t)(b * 64 + c)) * 64 + lane) * 64 + 16 * qg + q] = myword;
        }
        if (has_next) idx_park(L, rn, tid);
        __syncthreads();
    }
}

template <int CUR>
__device__ __forceinline__ void attn_step(LAS unsigned char* L, const int kt, const int c, const int fr, const int fq, const u16* kg, const u16* vg, const u64* mrow,
                                          const bf16x8 (&qf)[2][2], f32x4 (&SC)[4][2], f32x4 (&SN)[4][2], f32x4 (&O)[4][2], float (&lrun)[2], u32x4& kreg, u32x4& vreg, u64 (&mwn)[2],
                                          const int skey, const int sdg) {
    LAS unsigned char* Kn = L + (1 - CUR) * 18432;
    LAS unsigned char* Vc = L + CUR * 18432 + 9216;
    const u64 mw[2] = {(c >= 4) ? mwn[0] : ~0ull, (c >= 4) ? mwn[1] : ~0ull};
    {
        const int k2 = (kt + 2 < c) ? kt + 2 : c, k1 = (kt < c) ? kt + 1 : c;
        kreg = *(const u32x4*)(kg + (size_t)k2 * 64 * 256); vreg = *(const u32x4*)(vg + k1 * 64);
#pragma unroll
        for (int n = 0; n < 2; ++n) mwn[n] = mrow[(size_t)k1 * 64 + 16 * n];
    }
#pragma unroll
    for (int m = 0; m < 4; ++m) {
        const bf16x8 kf0 = *(const LAS bf16x8*)(Kn + ((16 * m + fr) * 72 + 8 * fq) * 2), kf1 = *(const LAS bf16x8*)(Kn + ((16 * m + fr) * 72 + 32 + 8 * fq) * 2);
#pragma unroll
        for (int n = 0; n < 2; ++n) {
            f32x4 z = {0.f, 0.f, 0.f, 0.f};
            z = __builtin_amdgcn_mfma_f32_16x16x32_bf16(kf0, qf[n][0], z, 0, 0, 0);
            SN[m][n] = __builtin_amdgcn_mfma_f32_16x16x32_bf16(kf1, qf[n][1], z, 0, 0, 0);
        }
    }
#pragma unroll
    for (int n = 0; n < 2; ++n) {
        const u64 ms = mw[n] >> (4 * fq);
        const int mlo = (int)(unsigned)ms, mhi = (int)(unsigned)(ms >> 32);
        float psum = 0.f;
#pragma unroll
        for (int m = 0; m < 4; ++m)
#pragma unroll
            for (int r = 0; r < 4; ++r) {
                int keep; asm("v_bfe_i32 %0, %1, %2, 1" : "=v"(keep) : "v"((m < 2) ? mlo : mhi), "n"(16 * (m & 1) + r));
                const float pv = __uint_as_float(__float_as_uint(__builtin_amdgcn_exp2f(SC[m][n][r])) & (unsigned)keep);
                SC[m][n][r] = pv; psum += pv;
            }
        lrun[n] += psum;
    }
#pragma unroll
    for (int kk = 0; kk < 2; ++kk) {
        bf16x8 pf[2];
#pragma unroll
        for (int n = 0; n < 2; ++n) {
            u32x4 w; w.x = pk2(SC[2 * kk][n][0], SC[2 * kk][n][1]); w.y = pk2(SC[2 * kk][n][2], SC[2 * kk][n][3]);
            w.z = pk2(SC[2 * kk + 1][n][0], SC[2 * kk + 1][n][1]); w.w = pk2(SC[2 * kk + 1][n][2], SC[2 * kk + 1][n][3]);
            pf[n] = as_bf16x8(w);
        }
#pragma unroll
        for (int md = 0; md < 4; ++md) {
            const u32x2 v0 = *(const LAS u32x2*)(Vc + ((16 * md + fr) * 72 + 32 * kk + 4 * fq) * 2), v1 = *(const LAS u32x2*)(Vc + ((16 * md + fr) * 72 + 32 * kk + 16 + 4 * fq) * 2);
            u32x4 w; w.x = v0.x; w.y = v0.y; w.z = v1.x; w.w = v1.y;
            const bf16x8 vf = as_bf16x8(w);
#pragma unroll
            for (int n = 0; n < 2; ++n) O[md][n] = __builtin_amdgcn_mfma_f32_16x16x32_bf16(vf, pf[n], O[md][n], 0, 0, 0);
        }
    }
    *(LAS u32x4*)(L + CUR * 18432 + (skey * 72 + sdg * 8) * 2) = kreg;
    *(LAS u32x4*)(L + (1 - CUR) * 18432 + 9216 + (skey * 72 + sdg * 8) * 2) = vreg;
    __syncthreads();
}

__device__ void attn_phase(const Params& p, LAS unsigned char* L, int reps) {
    const int tid = threadIdx.x, wid = tid >> 6, lane = tid & 63, fr = lane & 15, fq = lane >> 4, G = gridDim.x;
    const int hql = wid >> 1, half = wid & 1;
    unsigned char* ws = p.ws;
    const u16* qb = (const u16*)(ws + WS_QB); u16* yo = (u16*)(ws + WS_HB); const u16* kb = (const u16*)(ws + WS_KB); const u16* vT = (const u16*)(ws + WS_VT);
    const u64* maskT = (const u64*)(ws + WS_MASK);
    const int skey = tid >> 3, sdg = tid & 7;
    for (int k = 0; k * G < 2048 * reps; ++k) {
        int u = k * G + ((k & 1) ? (G - 1 - (int)blockIdx.x) : (int)blockIdx.x);
        if (u >= 2048 * reps) continue;
        u &= 2047;
        const int c = 63 - (u >> 5), b = (u >> 2) & 7, g = u & 3, hq = g * 4 + hql;
        const int tokq = b * T + 64 * c + 32 * half;
        bf16x8 qf[2][2];
#pragma unroll
        for (int n = 0; n < 2; ++n)
#pragma unroll
            for (int ks = 0; ks < 2; ++ks) qf[n][ks] = *(const bf16x8*)(qb + (size_t)(tokq + 16 * n + fr) * 1024 + hq * 64 + 32 * ks + 8 * fq);
        f32x4 O[4][2], SA[4][2], SB[4][2];
#pragma unroll
        for (int md = 0; md < 4; ++md)
#pragma unroll
            for (int n = 0; n < 2; ++n) O[md][n] = (f32x4){0.f, 0.f, 0.f, 0.f};
        float lrun[2] = {0.f, 0.f};
        const u16* kg = kb + (size_t)(b * T + skey) * 256 + g * 64 + sdg * 8;
        const u16* vg = vT + ((size_t)((b * 4 + g) * 64 + skey)) * T + sdg * 8;
        const u64* mrow = maskT + (((size_t)(b * 64 + c)) * 64) * 64 + 32 * half + fr;
        u64 mwn[2];
        u32x4 kreg, vreg;
        {
            const u32x4 k0 = *(const u32x4*)kg;
            kreg = *(const u32x4*)(kg + (size_t)((c >= 1) ? 1 : 0) * 64 * 256); vreg = *(const u32x4*)vg;
#pragma unroll
            for (int n = 0; n < 2; ++n) mwn[n] = mrow[16 * n];
            *(LAS u32x4*)(L + (skey * 72 + sdg * 8) * 2) = k0;
            __syncthreads();
#pragma unroll
            for (int m = 0; m < 4; ++m) {
                const bf16x8 kf0 = *(const LAS bf16x8*)(L + ((16 * m + fr) * 72 + 8 * fq) * 2), kf1 = *(const LAS bf16x8*)(L + ((16 * m + fr) * 72 + 32 + 8 * fq) * 2);
#pragma unroll
                for (int n = 0; n < 2; ++n) {
                    f32x4 z = {0.f, 0.f, 0.f, 0.f};
                    z = __builtin_amdgcn_mfma_f32_16x16x32_bf16(kf0, qf[n][0], z, 0, 0, 0);
                    SA[m][n] = __builtin_amdgcn_mfma_f32_16x16x32_bf16(kf1, qf[n][1], z, 0, 0, 0);
                }
            }
            *(LAS u32x4*)(L + 18432 + (skey * 72 + sdg * 8) * 2) = kreg;
            *(LAS u32x4*)(L + 9216 + (skey * 72 + sdg * 8) * 2) = vreg;
            __syncthreads();
        }
        for (int kt0 = 0; kt0 <= c; kt0 += 2) {
            attn_step<0>(L, kt0, c, fr, fq, kg, vg, mrow, qf, SA, SB, O, lrun, kreg, vreg, mwn, skey, sdg);
            if (kt0 + 1 <= c) attn_step<1>(L, kt0 + 1, c, fr, fq, kg, vg, mrow, qf, SB, SA, O, lrun, kreg, vreg, mwn, skey, sdg);
        }
#pragma unroll
        for (int n = 0; n < 2; ++n) {
            float l = lrun[n]; l += __shfl_xor(l, 16); l += __shfl_xor(l, 32);
            const float inv = 1.0f / l;
#pragma unroll
            for (int md = 0; md < 4; ++md) {
                const f32x4 o = O[md][n] * inv;
                u32x2 w; w.x = pk2(o[0], o[1]); w.y = pk2(o[2], o[3]);
                *(u32x2*)(yo + (size_t)(tokq + 16 * n + fr) * 1024 + hq * 64 + 16 * md + 4 * fq) = w;
            }
        }
    }
}

__device__ __noinline__ void grid_barrier_nv(unsigned* bar, unsigned x, volatile LAS unsigned* st) { XcdBarrier b; b.bar = bar; b.x = x; b.st = st; xcd_barrier(b); }
#define grid_barrier(B) grid_barrier_nv((B).bar, (B).x, (B).st)
__global__ void __launch_bounds__(512, 2) fwd_megakernel(Params p) {
    extern __shared__ __attribute__((aligned(16))) unsigned char shm[];
    LAS unsigned char* L = (LAS unsigned char*)shm;
    cg::grid_group grid = cg::this_grid();
    unsigned char* ws = p.ws;
    u16* gb = (u16*)p.out;
    volatile LAS unsigned* xst = (volatile LAS unsigned*)(L + 131072);
    if (threadIdx.x == 0) { xst[0] = 0u; xst[1] = 0u; xst[2] = 0u; xst[3] = 0u; }
    __syncthreads();
    const XcdBarrier xb = xcd_barrier_post((unsigned*)(ws + WS_BAR), xst);
#define PHASE(i) if (p.ph_lo <= (i) && (i) < p.ph_hi)
#define SEAM(i) if (p.ph_lo <= (i) && (i) + 1 < p.ph_hi) { if ((i) == 0 && p.pad_) grid.sync(); else grid_barrier(xb); }
#define REPS(bit) (1 + ((p.dbl >> (bit)) & 1))
    PHASE(0) { for (int rp0 = 0; rp0 < REPS(0); ++rp0) prepass(p); }
    SEAM(0);
    PHASE(1) {
        EpiG1 E; E.rx = (u16*)(ws + WS_RX); E.gt = (u16*)(ws + WS_GT); E.qb = (u16*)(ws + WS_QB); E.kb = (u16*)(ws + WS_KB); E.vb = (u16*)(ws + WS_VB); E.iq = (u16*)(ws + WS_IQ); E.gb = gb;
        E.ikw = (float*)(ws + WS_IKW); E.gate_b = p.in[I_GATEB];
        run_gemm(L, (const u16*)(ws + WS_HB), (const u16*)(ws + WS_WT_IN), NIN, 1024, E, REPS(1));
    }
    SEAM(1);
    PHASE(2) { rnn_phase<0>(p, L, REPS(2)); norm_phase(p); }
    SEAM(2);
    PHASE(3) { rnn_phase<1>(p, L, 1); indexer_phase(p, L, REPS(5)); }
    SEAM(3);
    PHASE(4) { attn_phase(p, L, REPS(6)); }
    SEAM(4);
    PHASE(5) {
        EpiGate2 E; E.O = (u16*)(ws + WS_RX); E.gb = gb;
        run_gemm2(L, (const u16*)(ws + WS_GT), (const u16*)(ws + WS_WT_ORNN), (const u16*)(ws + WS_HB), (const u16*)(ws + WS_WT_OATT), 1024, 1024, E);
    }
    SEAM(5);
    PHASE(6) {
        EpiRes1 E; E.x = p.in[I_X]; E.out = p.out; E.xw = (u16*)(ws + WS_XW); E.n2w = p.in[I_N2W]; E.rowss = (float*)(ws + WS_ROWSS);
        run_gemm(L, (const u16*)(ws + WS_RX), (const u16*)(ws + WS_WT_OUT), 1024, 1024, E);
    }
    SEAM(6);
    PHASE(7) {
        EpiFF1 E; E.hid = (u16*)(ws + WS_HID); E.rowss = (const float*)(ws + WS_ROWSS);
        run_gemm(L, (const u16*)(ws + WS_XW), (const u16*)(ws + WS_WT_FFIN), DFF, 1024, E, REPS(10));
    }
    SEAM(7);
    PHASE(8) {
        EpiRes2 E; E.out = p.out;
        run_gemm(L, (const u16*)(ws + WS_HID), (const u16*)(ws + WS_WT_FFOUT), 1024, DFF, E);
    }
#undef REPS
#undef PHASE
#undef SEAM
}

extern "C" void kernel_launch(void* const* d_in, const int* in_sizes, int n_in, void* d_out, int out_size, void* d_ws, size_t ws_size, hipStream_t stream) {
    static int grid_blocks = 0;
    if (grid_blocks == 0) {
        if (n_in != 20 || out_size != M * D || ws_size < WS_END) { fprintf(stderr, "kernel_launch: unexpected shapes (n_in %d out %d ws %zu)\n", n_in, out_size, ws_size); grid_blocks = -1; return; }
        int dev = 0, cus = 0, per_cu = 0;
        (void)hipGetDevice(&dev);
        (void)hipDeviceGetAttribute(&cus, hipDeviceAttributeMultiprocessorCount, dev);
        (void)hipFuncSetAttribute((const void*)fwd_megakernel, hipFuncAttributeMaxDynamicSharedMemorySize, LDS_BYTES);
        (void)hipOccupancyMaxActiveBlocksPerMultiprocessor(&per_cu, (const void*)fwd_megakernel, 512, LDS_BYTES);
        if (per_cu < 1) { fprintf(stderr, "kernel_launch: occupancy query says %d blocks per CU\n", per_cu); per_cu = 1; }
        grid_blocks = cus;
        fprintf(stderr, "kernel_launch: cus %d per_cu %d grid %d\n", cus, per_cu, grid_blocks);
    }
    if (grid_blocks < 0) return;
    Params p{};
    for (int i = 0; i < 20; ++i) p.in[i] = (const float*)d_in[i];
    p.out = (float*)d_out; p.ws = (unsigned char*)d_ws; p.ph_lo = 0; p.ph_hi = 9; p.dbl = PROBE_DBL;
    (void)hipMemsetAsync((unsigned char*)d_ws + WS_BAR, 0, XCD_BAR_WORDS * sizeof(unsigned), stream);
    void* args[] = {&p};
    hipError_t e = hipLaunchCooperativeKernel((const void*)fwd_megakernel, dim3(grid_blocks), dim3(512), args, LDS_BYTES, stream);
    if (e != hipSuccess) fprintf(stderr, "cooperative launch failed: %s (grid %d)\n", hipGetErrorString(e), grid_blocks);
}
```
